# Optimizing an MI355X kernel written in HIP

```python
import math
import jax, jax.numpy as jnp
from jax import lax
import numpy as np

D_MODEL = 1024
BATCH = 8
SEQ = 4096
DEPTH = 2

GRID_W = 64
CTX_LEN = 256
HEAD_DIM = 64
N_HEADS_TOTAL = D_MODEL // HEAD_DIM
A_HEADS = N_HEADS_TOTAL // 2
A_KV_HEADS = A_HEADS // 4
A_REP = A_HEADS // A_KV_HEADS
B_HEADS = N_HEADS_TOTAL // 4
C_HEADS = N_HEADS_TOTAL // 4
DIFF_DIM = HEAD_DIM // 2
WIN_H_MAX = 8
WIN_W = 16
Q_BLOCK = 128
FFN_DIM = ((8 * D_MODEL // 3 + 127) // 128) * 128
ROPE_THETA = 10000.0
EPS = 1e-6
IN_SIZES = (A_HEADS * HEAD_DIM, A_KV_HEADS * HEAD_DIM, A_KV_HEADS * HEAD_DIM,
            B_HEADS * HEAD_DIM, B_HEADS * HEAD_DIM, B_HEADS * HEAD_DIM,
            C_HEADS * HEAD_DIM, C_HEADS * HEAD_DIM, C_HEADS * HEAD_DIM)
IN_COLS = A_HEADS * HEAD_DIM + 2 * A_KV_HEADS * HEAD_DIM + 3 * B_HEADS * HEAD_DIM + 3 * C_HEADS * HEAD_DIM

kernel_name = "hybrid_gqa_natten_diffattn_convffn_prefix"


def rms_norm(x, g):
    xf = x.astype(jnp.float32)
    y = xf * lax.rsqrt(jnp.mean(xf * xf, axis=-1, keepdims=True) + EPS)
    return y.astype(x.dtype) * g


def modulate(h, shift, scale):
    return h * (1.0 + scale) + shift


def heads(t, n):
    b, s, _ = t.shape
    return t.reshape(b, s, n, -1).transpose(0, 2, 1, 3)


def diff_heads(t):
    b, s, _ = t.shape
    return t.reshape(b, s, C_HEADS, 2, DIFF_DIM).transpose(0, 2, 3, 1, 4)


def merge_heads(o):
    b, h, s, d = o.shape
    return o.transpose(0, 2, 1, 3).reshape(b, s, h * d)


def axial_rope_angles(L, dim):
    half = dim // 2
    inv = ROPE_THETA ** (-jnp.arange(0, half, 2, dtype=jnp.float32) / half)
    t = jnp.arange(L, dtype=jnp.int32)
    row = (t // GRID_W).astype(jnp.float32)
    col = (t % GRID_W).astype(jnp.float32)
    ang = jnp.concatenate([row[:, None] * inv, col[:, None] * inv], axis=-1)
    return jnp.cos(ang), jnp.sin(ang)


def apply_rope(x, cos, sin):
    x1, x2 = x[..., 0::2], x[..., 1::2]
    c = cos.astype(x.dtype)
    s = sin.astype(x.dtype)
    return jnp.stack([x1 * c - x2 * s, x1 * s + x2 * c], axis=-1).reshape(x.shape)


def sweep_blocks(fn, q, axis, out_axis):
    s = q.shape[axis]
    n = s // Q_BLOCK
    qb = jnp.moveaxis(q.reshape(q.shape[:axis] + (n, Q_BLOCK) + q.shape[axis + 1:]), axis, 0)
    o = jnp.moveaxis(lax.map(fn, qb), 0, out_axis)
    return o.reshape(o.shape[:out_axis] + (s,) + o.shape[out_axis + 2:])


def softmax_attend(q, kvs, s_spec, o_spec, scale):
    s = jnp.concatenate([jnp.einsum(s_spec, q, k, preferred_element_type=jnp.float32) for k, _ in kvs], axis=-1) * scale
    p = jax.nn.softmax(s, axis=-1)
    bounds = np.cumsum([k.shape[-2] for k, _ in kvs])[:-1].tolist()
    parts = jnp.split(p, bounds, axis=-1)
    terms = [jnp.einsum(o_spec, pi.astype(v.dtype), v) for pi, (_, v) in zip(parts, kvs)]
    return sum(terms[1:], terms[0])


def diff_attend(q, kvs, lam, scale):
    s = jnp.concatenate([jnp.einsum('bhmqd,bhmkd->bhmqk', q, k, preferred_element_type=jnp.float32)
                         for k, _ in kvs], axis=-1) * scale
    p = jax.nn.softmax(s, axis=-1)
    w = p[:, :, 0] - lam * p[:, :, 1]
    bounds = np.cumsum([k.shape[-2] for k, _ in kvs])[:-1].tolist()
    parts = jnp.split(w, bounds, axis=-1)
    terms = [jnp.einsum('bhqk,bhkd->bhqd', wi.astype(v.dtype), v) for wi, (_, v) in zip(parts, kvs)]
    return sum(terms[1:], terms[0])


def neighbourhood_attend(q, k, v, k_ctx, v_ctx, rpb):
    b, h, L, d = q.shape
    rows = L // GRID_W
    win_h = min(WIN_H_MAX, rows)
    n_win = win_h * WIN_W
    scale = d ** -0.5
    qg = q.reshape(b, h, rows, GRID_W, d)
    kg = k.reshape(b, h, rows, GRID_W, d)
    vg = v.reshape(b, h, rows, GRID_W, d)
    col = jnp.arange(GRID_W)
    col_idx = jnp.clip(col - WIN_W // 2, 0, GRID_W - WIN_W)[:, None] + jnp.arange(WIN_W)[None, :]
    col_bias = rpb[:, :, col_idx - col[:, None] + WIN_W - 1]

    def one_row(r):
        rs = jnp.clip(r - win_h // 2, 0, rows - win_h)
        q_r = lax.dynamic_index_in_dim(qg, r, axis=2, keepdims=False)
        k_win = lax.dynamic_slice_in_dim(kg, rs, win_h, axis=2)[:, :, :, col_idx]
        v_win = lax.dynamic_slice_in_dim(vg, rs, win_h, axis=2)[:, :, :, col_idx]
        row_off = rs + jnp.arange(win_h) - r
        bias = col_bias[:, row_off + WIN_H_MAX - 1].transpose(0, 2, 1, 3)
        s_win = jnp.einsum('bhqd,bhiqjd->bhqij', q_r, k_win, preferred_element_type=jnp.float32) * scale + bias
        s_ctx = jnp.einsum('bhqd,bhkd->bhqk', q_r, k_ctx, preferred_element_type=jnp.float32) * scale
        p = jax.nn.softmax(jnp.concatenate([s_win.reshape(b, h, GRID_W, n_win), s_ctx], axis=-1), axis=-1)
        p_win = p[..., :n_win].reshape(b, h, GRID_W, win_h, WIN_W).astype(v.dtype)
        p_ctx = p[..., n_win:].astype(v.dtype)
        return (jnp.einsum('bhqij,bhiqjd->bhqd', p_win, v_win)
                + jnp.einsum('bhqk,bhkd->bhqd', p_ctx, v_ctx))

    o = lax.map(one_row, jnp.arange(rows))
    return o.transpose(1, 2, 0, 3, 4).reshape(b, h, L, d)


def mixer_a(q, k, v, q_ctx, k_ctx, v_ctx, gq, gk, cos, sin, with_ctx):
    q = apply_rope(rms_norm(heads(q, A_HEADS), gq), cos, sin)
    k = apply_rope(rms_norm(heads(k, A_KV_HEADS), gk), cos, sin)
    v = heads(v, A_KV_HEADS)
    k_ctx = rms_norm(heads(k_ctx, A_KV_HEADS), gk)
    v_ctx = heads(v_ctx, A_KV_HEADS)
    b, _, L, d = q.shape
    scale = d ** -0.5
    s_spec, o_spec = 'bgrqd,bgkd->bgrqk', 'bgrqk,bgkd->bgrqd'
    qg = q.reshape(b, A_KV_HEADS, A_REP, L, d)
    o = sweep_blocks(lambda qb: softmax_attend(qb, ((k, v), (k_ctx, v_ctx)), s_spec, o_spec, scale), qg, 3, 3)
    out = merge_heads(o.reshape(b, A_HEADS, L, d))
    out_ctx = None
    if with_ctx:
        qc = rms_norm(heads(q_ctx, A_HEADS), gq)
        lc = qc.shape[2]
        oc = softmax_attend(qc.reshape(b, A_KV_HEADS, A_REP, lc, d), ((k_ctx, v_ctx),), s_spec, o_spec, scale)
        out_ctx = merge_heads(oc.reshape(b, A_HEADS, lc, d))
    return out, out_ctx


def mixer_b(q, k, v, q_ctx, k_ctx, v_ctx, gq, gk, rpb, with_ctx):
    q = rms_norm(heads(q, B_HEADS), gq)
    k = rms_norm(heads(k, B_HEADS), gk)
    v = heads(v, B_HEADS)
    k_ctx = rms_norm(heads(k_ctx, B_HEADS), gk)
    v_ctx = heads(v_ctx, B_HEADS)
    out = merge_heads(neighbourhood_attend(q, k, v, k_ctx, v_ctx, rpb))
    out_ctx = None
    if with_ctx:
        qc = rms_norm(heads(q_ctx, B_HEADS), gq)
        oc = softmax_attend(qc, ((k_ctx, v_ctx),), 'bhqd,bhkd->bhqk', 'bhqk,bhkd->bhqd', HEAD_DIM ** -0.5)
        out_ctx = merge_heads(oc)
    return out, out_ctx


def mixer_c(q, k, v, q_ctx, k_ctx, v_ctx, gq, gk, lq1, lk1, lq2, lk2, g_sub, lam_init, cos, sin, with_ctx):
    lam = (jnp.exp(jnp.sum(lq1.astype(jnp.float32) * lk1.astype(jnp.float32)))
           - jnp.exp(jnp.sum(lq2.astype(jnp.float32) * lk2.astype(jnp.float32))) + lam_init)
    q = apply_rope(rms_norm(diff_heads(q), gq), cos, sin)
    k = apply_rope(rms_norm(diff_heads(k), gk), cos, sin)
    v = heads(v, C_HEADS)
    k_ctx = rms_norm(diff_heads(k_ctx), gk)
    v_ctx = heads(v_ctx, C_HEADS)
    scale = DIFF_DIM ** -0.5
    o = sweep_blocks(lambda qb: diff_attend(qb, ((k, v), (k_ctx, v_ctx)), lam, scale), q, 3, 2)
    out = merge_heads(rms_norm(o, g_sub) * (1.0 - lam_init))
    out_ctx = None
    if with_ctx:
        qc = rms_norm(diff_heads(q_ctx), gq)
        oc = diff_attend(qc, ((k_ctx, v_ctx),), lam, scale)
        out_ctx = merge_heads(rms_norm(oc, g_sub) * (1.0 - lam_init))
    return out, out_ctx


def dwconv3(x, w, b):
    xp = jnp.pad(x, ((0, 0), (1, 1), (0, 0)))
    return xp[:, :-2] * w[0] + xp[:, 1:-1] * w[1] + xp[:, 2:] * w[2] + b


def conv_ffn(h, w_up, conv_w, conv_b, w_down):
    ug = dwconv3(h @ w_up, conv_w, conv_b)
    u, g = jnp.split(ug, 2, axis=-1)
    return (jax.nn.silu(g) * u) @ w_down


def setup_inputs(seed: int = 0) -> dict:
    key = jax.random.key(seed)
    ks = jax.random.split(key, 26)
    D = D_MODEL

    def nrm(k, shape, s):
        return jax.random.normal(k, shape, jnp.float32) * s

    return {
        "x": nrm(ks[0], (BATCH, SEQ, D), 1.0),
        "c": nrm(ks[1], (BATCH, D), 1.0),
        "ctx": nrm(ks[2], (BATCH, CTX_LEN, D), 1.0),
        "c_ctx": nrm(ks[3], (D,), 1.0),
        "w_ada": nrm(ks[4], (DEPTH, D, 6 * D), 0.5 * D ** -0.5),
        "b_ada": nrm(ks[5], (DEPTH, 6 * D), 0.01),
        "g_norm1": 1.0 + nrm(ks[6], (DEPTH, D), 0.01),
        "w_in": nrm(ks[7], (DEPTH, D, IN_COLS), D ** -0.5),
        "gq_a": 1.0 + nrm(ks[8], (DEPTH, HEAD_DIM), 0.01),
        "gk_a": 1.0 + nrm(ks[9], (DEPTH, HEAD_DIM), 0.01),
        "gq_b": 1.0 + nrm(ks[10], (DEPTH, HEAD_DIM), 0.01),
        "gk_b": 1.0 + nrm(ks[11], (DEPTH, HEAD_DIM), 0.01),
        "rpb_b": nrm(ks[12], (DEPTH, B_HEADS, 2 * WIN_H_MAX - 1, 2 * WIN_W - 1), 0.02),
        "gq_c": 1.0 + nrm(ks[13], (DEPTH, DIFF_DIM), 0.01),
        "gk_c": 1.0 + nrm(ks[14], (DEPTH, DIFF_DIM), 0.01),
        "lambda_q1": nrm(ks[15], (DEPTH, DIFF_DIM), 0.1),
        "lambda_k1": nrm(ks[16], (DEPTH, DIFF_DIM), 0.1),
        "lambda_q2": nrm(ks[17], (DEPTH, DIFF_DIM), 0.1),
        "lambda_k2": nrm(ks[18], (DEPTH, DIFF_DIM), 0.1),
        "g_subln": 1.0 + nrm(ks[19], (DEPTH, 2 * DIFF_DIM), 0.01),
        "w_out": nrm(ks[20], (DEPTH, D, D), D ** -0.5),
        "g_norm2": 1.0 + nrm(ks[21], (DEPTH, D), 0.01),
        "w_up": nrm(ks[22], (DEPTH, D, 2 * FFN_DIM), D ** -0.5),
        "conv_w": nrm(ks[23], (DEPTH, 3, 2 * FFN_DIM), 3 ** -0.5),
        "conv_b": nrm(ks[24], (DEPTH, 2 * FFN_DIM), 0.01),
        "w_down": nrm(ks[25], (DEPTH, FFN_DIM, D), FFN_DIM ** -0.5),
    }


def reference(x, c, ctx, c_ctx, w_ada, b_ada, g_norm1, w_in, gq_a, gk_a, gq_b, gk_b, rpb_b, gq_c, gk_c,
              lambda_q1, lambda_k1, lambda_q2, lambda_k2, g_subln, w_out, g_norm2, w_up, conv_w, conv_b, w_down):
    L = x.shape[1]
    cos_a, sin_a = axial_rope_angles(L, HEAD_DIM)
    cos_c, sin_c = axial_rope_angles(L, DIFF_DIM)
    silu_c = jax.nn.silu(c)
    silu_cc = jax.nn.silu(c_ctx)
    bounds = np.cumsum(IN_SIZES)[:-1].tolist()
    for l in range(DEPTH):
        with_ctx = l < DEPTH - 1
        lam_init = 0.8 - 0.6 * math.exp(-0.3 * l)
        mod_x = (silu_c @ w_ada[l] + b_ada[l])[:, None, :]
        mod_c = (silu_cc @ w_ada[l] + b_ada[l])[None, None, :]
        sh1_x, sc1_x, gt1_x, sh2_x, sc2_x, gt2_x = jnp.split(mod_x, 6, axis=-1)
        sh1_c, sc1_c, gt1_c, sh2_c, sc2_c, gt2_c = jnp.split(mod_c, 6, axis=-1)

        hx = modulate(rms_norm(x, g_norm1[l]), sh1_x, sc1_x)
        hc = modulate(rms_norm(ctx, g_norm1[l]), sh1_c, sc1_c)
        qa, ka, va, qb, kb, vb, qc, kc, vc = jnp.split(hx @ w_in[l], bounds, axis=-1)
        qa_t, ka_t, va_t, qb_t, kb_t, vb_t, qc_t, kc_t, vc_t = jnp.split(hc @ w_in[l], bounds, axis=-1)

        oa, oa_t = mixer_a(qa, ka, va, qa_t, ka_t, va_t, gq_a[l], gk_a[l], cos_a, sin_a, with_ctx)
        ob, ob_t = mixer_b(qb, kb, vb, qb_t, kb_t, vb_t, gq_b[l], gk_b[l], rpb_b[l], with_ctx)
        oc, oc_t = mixer_c(qc, kc, vc, qc_t, kc_t, vc_t, gq_c[l], gk_c[l], lambda_q1[l], lambda_k1[l],
                           lambda_q2[l], lambda_k2[l], g_subln[l], lam_init, cos_c, sin_c, with_ctx)

        x = x + gt1_x * (jnp.concatenate([oa, ob, oc], axis=-1) @ w_out[l])
        hx2 = modulate(rms_norm(x, g_norm2[l]), sh2_x, sc2_x)
        x = x + gt2_x * conv_ffn(hx2, w_up[l], conv_w[l], conv_b[l], w_down[l])

        if with_ctx:
            ctx = ctx + gt1_c * (jnp.concatenate([oa_t, ob_t, oc_t], axis=-1) @ w_out[l])
            hc2 = modulate(rms_norm(ctx, g_norm2[l]), sh2_c, sc2_c)
            ctx = ctx + gt2_c * conv_ffn(hc2, w_up[l], conv_w[l], conv_b[l], w_down[l])
    return x
```

```cpp
#include <hip/hip_runtime.h>
#include <hip/hip_cooperative_groups.h>
#include <cstdio>
#include <cstdint>
namespace cg = cooperative_groups;
namespace pg8 {
#define PG8_LAS __attribute__((address_space(3)))
typedef unsigned short bf16_t;
typedef short bf16x8 __attribute__((ext_vector_type(8)));
typedef float f32x4 __attribute__((ext_vector_type(4)));
typedef unsigned u32x4 __attribute__((ext_vector_type(4)));
constexpr int BM = 256, BK = 64, HALF = 128, HTB = HALF * BK * 2  , STAGE_BYTES = 8 * HTB, NXCD = 8, WGM = 8;

__host__ __device__ __forceinline__ int lds_byte(int r, int c) { const int st = (r >> 4) * 2 + (c >> 5), rr = r & 15, cc = c & 31, ob = rr * 64 + cc * 2; return st * 1024 + (ob ^ (((ob >> 9) & 1) << 5)); }
__host__ __device__ __forceinline__ void stage_rc(int b, int& R, int& C) { const int st = b / 1024, sb = b % 1024, swz = sb ^ (((sb >> 9) & 1) << 5); R = (st >> 1) * 16 + swz / 64; C = (st & 1) * 32 + (swz % 64) / 2; }
__host__ __device__ __forceinline__ int perm32(int rho) { const int n = rho >> 4, i = rho & 15; return 8 * (i >> 2) + 4 * n + (i & 3); }

struct Unit { int pm, pn; };
struct Gemm { const bf16_t* A; const bf16_t* Bt; int M, N, K; };

struct StaticOrder {
    int nM, nN, nwg, G, c;
    __host__ __device__ void init(int M, int N, int G_, int c_) { nM = M / BM; nN = N / BM; nwg = nM * nN; G = G_; c = c_; }
    __host__ __device__ bool next(int i, Unit& u) const {
        const long L = (long)i * G + c; if (L >= nwg) return false;
        int wgid = (int)L; { const int q = nwg / NXCD, r = nwg % NXCD, xcd = wgid % NXCD, off = wgid / NXCD; wgid = (xcd < r ? xcd * (q + 1) : r * (q + 1) + (xcd - r) * q) + off; }
        const int nig = WGM * nN, gid = wgid / nig, fm = gid * WGM, gsz = (nM - fm) < WGM ? (nM - fm) : WGM;
        u.pm = fm + ((wgid % nig) % gsz); u.pn = (wgid % nig) / gsz; return true;
    }
    __device__ __forceinline__ void a_ready(const Unit&) const {}
    __device__ __forceinline__ void done(const Unit&) const {}
};

__device__ __forceinline__ unsigned cvt_pk_bf16(float lo, float hi) { unsigned r; asm volatile("v_cvt_pk_bf16_f32 %0, %1, %2" : "=v"(r) : "v"(lo), "v"(hi)); return r; }
typedef float f32x2 __attribute__((ext_vector_type(2)));
__device__ __forceinline__ f32x2 gelu_pk(f32x2 v) {
    const f32x2 av = __builtin_elementwise_abs(v), d = av * 0.2316418882f + 1.0f;
    f32x2 t; t.x = __builtin_amdgcn_rcpf(d.x); t.y = __builtin_amdgcn_rcpf(d.y);
    f32x2 q = t * 0.5307027145f + (-0.7265760135f); q = q * t + 0.7107068705f; q = q * t + (-0.142248368f); q = q * t + 0.127414796f; q = q * t;
    const f32x2 s = (v * v) * (-0.72134752044f);
    f32x2 e; e.x = __builtin_amdgcn_exp2f(s.x); e.y = __builtin_amdgcn_exp2f(s.y);
    const f32x2 m = v * (q * e), r = v - m;
    f32x2 o; o.x = v.x < 0.f ? m.x : r.x; o.y = v.y < 0.f ? m.y : r.y; return o;
}

template <int ACT  > struct EpiBf16 {
    static constexpr bool PERM = true, AFTER_DRAIN = false; static_assert(ACT == 0 || ACT == 1, "EpiBf16: ACT is 0 (none) or 1 (gelu_pk)");
    bf16_t* O; int ldc; const float* bias; int split_cols; size_t split_stride; float scale0;
    __device__ __forceinline__ void operator()(const f32x4 (&acc)[2][2][4][2], const Unit& u, int wr, int wc, int fr, int fq) const {
        const int row0 = u.pm * BM + wr * 64 + fr; int colt = u.pn * BM; bf16_t* base = O;
        float sc = 1.f; if (split_cols) { const int t = colt / split_cols; base += (size_t)t * split_stride; colt -= t * split_cols; if (t == 0) sc = scale0; }
        const int col0 = colt + wc * 32 + 8 * fq, bcol0 = u.pn * BM + wc * 32 + 8 * fq;
        f32x4 bv[2][2];
#pragma unroll
        for (int bj = 0; bj < 2; ++bj)
#pragma unroll
            for (int n = 0; n < 2; ++n) bv[bj][n] = bias ? *(const f32x4*)(bias + bcol0 + bj * HALF + 4 * n) : (f32x4){0.f, 0.f, 0.f, 0.f};
#pragma unroll
        for (int ai = 0; ai < 2; ++ai)
#pragma unroll
            for (int m = 0; m < 4; ++m) { bf16_t* rowp = base + (size_t)(row0 + ai * HALF + m * 16) * ldc + col0;
#pragma unroll
                for (int bj = 0; bj < 2; ++bj) { f32x4 v0 = acc[ai][bj][m][0] + bv[bj][0], v1 = acc[ai][bj][m][1] + bv[bj][1];
                    if (ACT == 1) { f32x2 a = gelu_pk((f32x2){v0[0], v0[1]}), b = gelu_pk((f32x2){v0[2], v0[3]}), c = gelu_pk((f32x2){v1[0], v1[1]}), d = gelu_pk((f32x2){v1[2], v1[3]});
                        v0 = (f32x4){a.x, a.y, b.x, b.y}; v1 = (f32x4){c.x, c.y, d.x, d.y}; }
                    v0 = v0 * sc; v1 = v1 * sc; u32x4 w; w.x = cvt_pk_bf16(v0[0], v0[1]); w.y = cvt_pk_bf16(v0[2], v0[3]); w.z = cvt_pk_bf16(v1[0], v1[1]); w.w = cvt_pk_bf16(v1[2], v1[3]);
                    *(u32x4*)(rowp + bj * HALF) = w; } }
    }
};
constexpr int P_S = 4096, P_CTX = 256, P_ST = 4352, P_NSLOT = 36, P_LAT_ROWS = 32768;
constexpr float P_EPS = 1e-6f, P_LOG2E = 1.4426950408889634f;
typedef float f32x2e __attribute__((ext_vector_type(2)));
struct QkvArgs { const float* in[26]; float* out; unsigned char* ws; };
typedef const __attribute__((address_space(4))) QkvArgs* QkvArgsP;
struct EpiQKV {
    static constexpr bool PERM = true, AFTER_DRAIN = false;
    QkvArgsP A; int l; unsigned qkv_off, tab_off;
    __device__ __forceinline__ void operator()(const f32x4 (&acc)[2][2][4][2], const Unit& u, int wr, int wc, int fr, int fq) const {
        asm volatile("" : "+v"(fr), "+v"(fq));
        const int slot = u.pn * 4 + wc;
        int b, tok0; const bool lat = u.pm < 128;
        if (lat) { b = u.pm >> 4; tok0 = (u.pm & 15) * 256; } else { b = u.pm - 128; tok0 = P_S; }
        unsigned char* ws = A->ws;
        bf16_t* QKV = (bf16_t*)(ws + qkv_off); const float* tabA = (const float*)(ws + tab_off); const float* tabC = tabA + 2048;
        const float* g = nullptr; int rope = 0; bool half = false; float qs = 1.f;
        if (slot < 8) { g = A->in[8] + l * 64; rope = 1; qs = 0.125f * P_LOG2E; }
        else if (slot < 10) { g = A->in[9] + l * 64; rope = 1; }
        else if (slot < 12) { }
        else if (slot < 16) { g = A->in[10] + l * 64; qs = 0.125f * P_LOG2E; }
        else if (slot < 20) { g = A->in[11] + l * 64; }
        else if (slot < 24) { }
        else if (slot < 28) { g = A->in[13] + l * 32; rope = 2; half = true; qs = 0.17677669529663687f * P_LOG2E; }
        else if (slot < 32) { g = A->in[14] + l * 32; rope = 2; half = true; }
        if (!lat) rope = 0;
        f32x4 gv[2][2];
#pragma unroll
        for (int bj = 0; bj < 2; ++bj)
#pragma unroll
            for (int n = 0; n < 2; ++n) gv[bj][n] = g ? *(const f32x4*)(g + (half ? 0 : 32 * bj) + 8 * fq + 4 * n) : (f32x4){1.f, 1.f, 1.f, 1.f};
        bf16_t* base = QKV + ((size_t)(b * P_NSLOT + slot) * P_ST + tok0) * 64 + 8 * fq;
#pragma unroll
        for (int ai = 0; ai < 2; ++ai)
#pragma unroll
            for (int m = 0; m < 4; ++m) {
                const int R = ai * HALF + wr * 64 + m * 16 + fr;
                f32x4 v[2][2];
#pragma unroll
                for (int bj = 0; bj < 2; ++bj)
#pragma unroll
                    for (int n = 0; n < 2; ++n) v[bj][n] = acc[ai][bj][m][n];
                if (g) {
                    float ss[2];
#pragma unroll
                    for (int bj = 0; bj < 2; ++bj) { float s = 0.f;
#pragma unroll
                        for (int n = 0; n < 2; ++n) s += (v[bj][n][0] * v[bj][n][0] + v[bj][n][1] * v[bj][n][1]) + (v[bj][n][2] * v[bj][n][2] + v[bj][n][3] * v[bj][n][3]);
                        s += __shfl_xor(s, 16); s += __shfl_xor(s, 32); ss[bj] = s; }
                    float rs[2];
                    if (half) { rs[0] = rsqrtf(ss[0] * (1.f / 32.f) + P_EPS); rs[1] = rsqrtf(ss[1] * (1.f / 32.f) + P_EPS); }
                    else { rs[0] = rsqrtf((ss[0] + ss[1]) * (1.f / 64.f) + P_EPS); rs[1] = rs[0]; }
#pragma unroll
                    for (int bj = 0; bj < 2; ++bj)
#pragma unroll
                        for (int n = 0; n < 2; ++n) v[bj][n] = (v[bj][n] * rs[bj]) * gv[bj][n];
                    if (rope) {
                        const int tok = tok0 + R, rowpos = tok >> 6, colpos = tok & 63;
#pragma unroll
                        for (int bj = 0; bj < 2; ++bj) {
                            const float* tp;
                            if (rope == 1) tp = tabA + ((bj == 0 ? rowpos : colpos) * 16 + 4 * fq) * 2;
                            else tp = tabC + ((fq < 2 ? rowpos : colpos) * 8 + 4 * (fq & 1)) * 2;
                            const f32x4 t0 = *(const f32x4*)tp, t1 = *(const f32x4*)(tp + 4);
                            { const f32x4 y = v[bj][0]; v[bj][0] = (f32x4){y[0] * t0[0] - y[1] * t0[1], y[0] * t0[1] + y[1] * t0[0], y[2] * t0[2] - y[3] * t0[3], y[2] * t0[3] + y[3] * t0[2]}; }
                            { const f32x4 y = v[bj][1]; v[bj][1] = (f32x4){y[0] * t1[0] - y[1] * t1[1], y[0] * t1[1] + y[1] * t1[0], y[2] * t1[2] - y[3] * t1[3], y[2] * t1[3] + y[3] * t1[2]}; }
                        }
                    }
                }
                bf16_t* rowp = base + (unsigned)(R * 64);
#pragma unroll
                for (int bj = 0; bj < 2; ++bj) { const f32x4 v0 = v[bj][0] * qs, v1 = v[bj][1] * qs;
                    u32x4 w; w.x = cvt_pk_bf16(v0[0], v0[1]); w.y = cvt_pk_bf16(v0[2], v0[3]); w.z = cvt_pk_bf16(v1[0], v1[1]); w.w = cvt_pk_bf16(v1[2], v1[3]);
                    *(u32x4*)(rowp + 32 * bj) = w; }
                asm volatile("" ::: "memory"); __builtin_amdgcn_sched_barrier(0);
            }
    }
};
struct EpiGateRes {
    static constexpr bool PERM = true, AFTER_DRAIN = false;
    const float* base_lat; const float* base_ctx; float* out_lat; float* out_ctx; const float* gate; int gate_stride; int row_off;
    __device__ __forceinline__ void operator()(const f32x4 (&acc)[2][2][4][2], const Unit& u, int wr, int wc, int fr, int fq) const {
        asm volatile("" : "+v"(fr), "+v"(fq));
        const int r0 = row_off + u.pm * BM;
        const bool lat = r0 < P_LAT_ROWS;
        const int brow = lat ? (r0 >> 12) : 8;
        const float* bp = lat ? base_lat + (size_t)r0 * 1024 : base_ctx + (size_t)(r0 - P_LAT_ROWS) * 1024;
        float* op = lat ? out_lat + (size_t)r0 * 1024 : out_ctx + (size_t)(r0 - P_LAT_ROWS) * 1024;
        const int col0 = u.pn * BM + wc * 32 + 8 * fq;
        f32x4 gv[2][2];
#pragma unroll
        for (int bj = 0; bj < 2; ++bj)
#pragma unroll
            for (int n = 0; n < 2; ++n) gv[bj][n] = *(const f32x4*)(gate + (size_t)brow * gate_stride + col0 + bj * HALF + 4 * n);
#pragma unroll
        for (int ai = 0; ai < 2; ++ai)
#pragma unroll
            for (int m = 0; m < 4; ++m) { const unsigned off = (unsigned)(ai * HALF + wr * 64 + m * 16 + fr) * 1024u + (unsigned)col0;
#pragma unroll
                for (int bj = 0; bj < 2; ++bj)
#pragma unroll
                    for (int n = 0; n < 2; ++n) { const f32x4 bs = *(const f32x4*)(bp + off + bj * HALF + 4 * n);
                        *(f32x4*)(op + off + bj * HALF + 4 * n) = bs + gv[bj][n] * acc[ai][bj][m][n]; }
                asm volatile("" ::: "memory"); }
    }
};
template <class Epi, class Sched, bool ALIGN_EPI = false, bool SP2 = false>
__device__ __forceinline__ void gemm_phase(PG8_LAS unsigned char* lds, const Gemm g, const Sched& S, const Epi& E) {
    int tid_ = threadIdx.x; asm volatile("" : "+v"(tid_));
    const int tid = tid_, wid = __builtin_amdgcn_readfirstlane(tid >> 6), lane = tid & 63, wr = wid >> 2, wc = wid & 3, fr = lane & 15, fq = lane >> 4;
    const int K = g.K, nt = K / BK;
    unsigned voffA[2], voffB[2];
#pragma unroll
    for (int i = 0; i < 2; ++i) { int R, C; stage_rc(tid * 16 + i * 8192, R, C); const int Rb = Epi::PERM ? ((R & ~31) + perm32(R & 31)) : R;
        voffA[i] = (unsigned)(R * K + C) * 2u; voffB[i] = (unsigned)(Rb * K + C) * 2u; }
    const size_t kstep = (size_t)(BK * 2);
    const size_t hstep = (size_t)HALF * K * 2;
    const size_t tstep = 2 * hstep;
    const unsigned ldsw = (unsigned)wid * 1024u;
    const int aoff = lds_byte(wr * 64 + fr, fq * 8), boff = lds_byte(wc * 32 + fr, fq * 8);
#define PG8_SA(b, h) (((b) * 2 + (h)) * HTB)
#define PG8_SB(b, h) ((4 + (b) * 2 + (h)) * HTB)
#define PG8_STAGE(bufoff, gbase, voff) do { _Pragma("unroll") for (int _i = 0; _i < 2; ++_i) \
        __builtin_amdgcn_global_load_lds((const unsigned*)((const char*)(gbase) + (voff)[_i]), (PG8_LAS unsigned*)(lds + (bufoff) + ldsw + _i * 8192), 16, 0, 0); } while (0)
#define PG8_LDA(dst, b, h) do { _Pragma("unroll") for (int m = 0; m < 4; ++m) _Pragma("unroll") for (int k = 0; k < 2; ++k) dst[m][k] = *(const PG8_LAS bf16x8*)(lds + PG8_SA(b, h) + aoff + m * 2048 + k * 1024); } while (0)
#define PG8_LDB(dst, b, h) do { _Pragma("unroll") for (int n = 0; n < 2; ++n) _Pragma("unroll") for (int k = 0; k < 2; ++k) dst[n][k] = *(const PG8_LAS bf16x8*)(lds + PG8_SB(b, h) + boff + n * 2048 + k * 1024); } while (0)
#define PG8_MMA(ai, bj, At, Bt) do { __builtin_amdgcn_s_setprio(1); _Pragma("unroll") for (int m = 0; m < 4; ++m) _Pragma("unroll") for (int n = 0; n < 2; ++n) _Pragma("unroll") for (int k = 0; k < 2; ++k) \
        acc[ai][bj][m][n] = __builtin_amdgcn_mfma_f32_16x16x32_bf16(Bt[n][k], At[m][k], acc[ai][bj][m][n], 0, 0, 0); __builtin_amdgcn_s_setprio(0); } while (0)
#define PG8_WAIT_V(n) asm volatile("s_waitcnt vmcnt(" #n ")" ::: "memory")
#define PG8_WAIT_L(n) asm volatile("s_waitcnt lgkmcnt(" #n ")" ::: "memory")
#define PG8_BAR __builtin_amdgcn_s_barrier()
#define PG8_SCHED __builtin_amdgcn_sched_barrier(0)
    Unit cur, nxt; int ui = 0;
    if (!S.next(0, cur)) return;
    f32x4 acc[2][2][4][2];
#pragma unroll
    for (int a = 0; a < 2; ++a)
#pragma unroll
        for (int b = 0; b < 2; ++b)
#pragma unroll
            for (int m = 0; m < 4; ++m)
#pragma unroll
                for (int n = 0; n < 2; ++n) acc[a][b][m][n] = (f32x4){0.f, 0.f, 0.f, 0.f};
    bf16x8 At[4][2], B0[2][2], B1[2][2];
    const char* cA = (const char*)g.A + (size_t)cur.pm * tstep; const char* cB = (const char*)g.Bt + (size_t)cur.pn * tstep;
    S.a_ready(cur);
    if constexpr (SP2) {
        PG8_STAGE(PG8_SB(0, 0), cB, voffB); PG8_STAGE(PG8_SB(0, 1), cB + hstep, voffB); PG8_STAGE(PG8_SA(0, 0), cA, voffA); PG8_STAGE(PG8_SA(0, 1), cA + hstep, voffA);
        if (wr == 1) PG8_BAR;
        PG8_WAIT_V(2); PG8_BAR;
        PG8_STAGE(PG8_SB(1, 0), cB + kstep, voffB); PG8_STAGE(PG8_SA(1, 0), cA + kstep, voffA); PG8_STAGE(PG8_SB(1, 1), cB + hstep + kstep, voffB);
        PG8_WAIT_V(6); PG8_BAR;
    } else {
        PG8_STAGE(PG8_SB(0, 0), cB, voffB); PG8_STAGE(PG8_SA(0, 0), cA, voffA); PG8_STAGE(PG8_SB(0, 1), cB + hstep, voffB); PG8_STAGE(PG8_SA(0, 1), cA + hstep, voffA);
        if (wr == 1) PG8_BAR;
        PG8_WAIT_V(4); PG8_BAR;
        PG8_STAGE(PG8_SB(1, 0), cB + kstep, voffB); PG8_STAGE(PG8_SA(1, 0), cA + kstep, voffA); PG8_STAGE(PG8_SB(1, 1), cB + hstep + kstep, voffB);
        PG8_WAIT_V(6); PG8_BAR;
    }
    for (;;) {
        const bool has_next = S.next(ui + 1, nxt);
        const char* nA = has_next ? (const char*)g.A + (size_t)nxt.pm * tstep : cA; const char* nB = has_next ? (const char*)g.Bt + (size_t)nxt.pn * tstep : cB;
        for (int t = 0; t < nt; t += 2) {
            const bool last = (t == nt - 2);
            const char* a1 = cA + (size_t)(t + 1) * kstep;
            const char* a2 = last ? nA : cA + (size_t)(t + 2) * kstep; const char* b2 = last ? nB : cB + (size_t)(t + 2) * kstep;
            const char* a3 = a2 + kstep; const char* b3 = b2 + kstep;
            if (last && has_next) S.a_ready(nxt);
            if constexpr (SP2) {
            PG8_LDB(B0, 0, 0); PG8_LDB(B1, 0, 1); PG8_SCHED; PG8_LDA(At, 0, 0); PG8_STAGE(PG8_SA(1, 1), a1 + hstep, voffA);
            PG8_WAIT_V(8); PG8_WAIT_L(0); PG8_BAR; PG8_MMA(0, 0, At, B0); PG8_MMA(0, 1, At, B1); PG8_BAR; PG8_SCHED;
            PG8_LDA(At, 0, 1); PG8_STAGE(PG8_SB(0, 0), b2, voffB); PG8_STAGE(PG8_SB(0, 1), b2 + hstep, voffB); PG8_STAGE(PG8_SA(0, 0), a2, voffA);
            PG8_WAIT_V(8); PG8_WAIT_L(0); PG8_BAR; PG8_MMA(1, 0, At, B0); PG8_MMA(1, 1, At, B1); PG8_BAR; PG8_SCHED;
            PG8_LDB(B0, 1, 0); PG8_LDB(B1, 1, 1); PG8_SCHED; PG8_LDA(At, 1, 0); PG8_STAGE(PG8_SA(0, 1), a2 + hstep, voffA);
            PG8_WAIT_V(8); PG8_WAIT_L(0); PG8_BAR; PG8_MMA(0, 0, At, B0); PG8_MMA(0, 1, At, B1); PG8_BAR; PG8_SCHED;
            PG8_LDA(At, 1, 1); PG8_STAGE(PG8_SB(1, 0), b3, voffB); PG8_STAGE(PG8_SB(1, 1), b3 + hstep, voffB); PG8_STAGE(PG8_SA(1, 0), a3, voffA);
            PG8_WAIT_V(8); PG8_WAIT_L(0); PG8_BAR; PG8_MMA(1, 0, At, B0); PG8_MMA(1, 1, At, B1); PG8_BAR; PG8_SCHED;
            } else {
            PG8_LDB(B0, 0, 0); PG8_SCHED; PG8_LDA(At, 0, 0); PG8_STAGE(PG8_SA(1, 1), a1 + hstep, voffA);
            PG8_WAIT_L(8); PG8_BAR; PG8_WAIT_L(0); PG8_MMA(0, 0, At, B0); PG8_BAR; PG8_SCHED;
            PG8_LDB(B1, 0, 1); PG8_STAGE(PG8_SB(0, 0), b2, voffB);
            PG8_BAR; PG8_WAIT_L(0); PG8_MMA(0, 1, At, B1); PG8_BAR;
            PG8_LDA(At, 0, 1); PG8_STAGE(PG8_SA(0, 0), a2, voffA);
            PG8_BAR; PG8_WAIT_L(0); PG8_MMA(1, 0, At, B0); PG8_BAR; PG8_SCHED;
            PG8_STAGE(PG8_SB(0, 1), b2 + hstep, voffB);
            PG8_WAIT_V(6); PG8_BAR; PG8_MMA(1, 1, At, B1); PG8_BAR;
            PG8_LDB(B0, 1, 0); PG8_SCHED; PG8_LDA(At, 1, 0); PG8_STAGE(PG8_SA(0, 1), a2 + hstep, voffA);
            PG8_WAIT_L(8); PG8_BAR; PG8_WAIT_L(0); PG8_MMA(0, 0, At, B0); PG8_BAR; PG8_SCHED;
            PG8_LDB(B1, 1, 1); PG8_STAGE(PG8_SB(1, 0), b3, voffB);
            PG8_BAR; PG8_WAIT_L(0); PG8_MMA(0, 1, At, B1); PG8_BAR;
            PG8_LDA(At, 1, 1); PG8_STAGE(PG8_SA(1, 0), a3, voffA);
            PG8_BAR; PG8_WAIT_L(0); PG8_MMA(1, 0, At, B0); PG8_BAR; PG8_SCHED;
            PG8_STAGE(PG8_SB(1, 1), b3 + hstep, voffB);
            PG8_WAIT_V(6); PG8_BAR; PG8_MMA(1, 1, At, B1); PG8_BAR;
            }
        }
        if constexpr (ALIGN_EPI) { if (wr == 0) PG8_BAR; }
        if constexpr (!Epi::AFTER_DRAIN) { E(acc, cur, wr, wc, fr, fq); S.done(cur); }
        if (!has_next) break;
#pragma unroll
        for (int a = 0; a < 2; ++a)
#pragma unroll
            for (int b = 0; b < 2; ++b)
#pragma unroll
                for (int m = 0; m < 4; ++m)
#pragma unroll
                    for (int n = 0; n < 2; ++n) acc[a][b][m][n] = (f32x4){0.f, 0.f, 0.f, 0.f};
        cur = nxt; cA = nA; cB = nB; ++ui;
        if constexpr (ALIGN_EPI) { if (wr == 1) PG8_BAR; }
    }
    PG8_WAIT_V(0);
    if constexpr (!ALIGN_EPI) { if (wr == 0) PG8_BAR; }
    PG8_BAR;
    if constexpr (Epi::AFTER_DRAIN) { E.fused(acc, cur, wr, wc, fr, fq, lds, wid, lane); S.done(cur); }
#undef PG8_SA
#undef PG8_SB
#undef PG8_STAGE
#undef PG8_LDA
#undef PG8_LDB
#undef PG8_MMA
#undef PG8_WAIT_V
#undef PG8_WAIT_L
#undef PG8_BAR
#undef PG8_SCHED
}
}
namespace att {
#define ATT_LAS __attribute__((address_space(3)))
typedef unsigned short bf16_t;
typedef short bf16x8 __attribute__((ext_vector_type(8)));
typedef float f32x16 __attribute__((ext_vector_type(16)));
typedef float f32x2 __attribute__((ext_vector_type(2)));
typedef __bf16 bf16x2v __attribute__((ext_vector_type(2)));
typedef unsigned u32x4 __attribute__((ext_vector_type(4)));
typedef unsigned u32x2 __attribute__((ext_vector_type(2)));
constexpr int ST = 4352, NSLOT = 36, SEQ = 4096, LAT_ROWS = 32768;
constexpr int RS = 144;
constexpr int TILE_B = 64 * RS;
constexpr int STAGE_B = 2 * TILE_B;
constexpr int LDS_RPB = 2 * STAGE_B;
constexpr int LDS_BYTES = LDS_RPB + 2048;
#define MFMA32(a, b, c) __builtin_amdgcn_mfma_f32_32x32x16_bf16((a), (b), (c), 0, 0, 0)
__device__ __forceinline__ unsigned pk(float lo, float hi) { f32x2 v = {lo, hi}; bf16x2v b = __builtin_convertvector(v, bf16x2v); return __builtin_bit_cast(unsigned, b); }
__device__ __forceinline__ float ex2(float x) { return __builtin_amdgcn_exp2f(x); }

struct Params { const bf16_t* QKV; bf16_t* O; const float* rpb; const float* gsub; float lam; float one_m_lam_init; };

__device__ __forceinline__ void softmax_step(f32x16& x, float& m, float& l, f32x16 (&o)[2], bf16x8 (&pb)[2]) {
    float mt = x[0];
#pragma unroll
    for (int i = 1; i < 16; ++i) mt = fmaxf(mt, x[i]);
    mt = fmaxf(mt, __shfl_xor(mt, 32));
    const float mn = fmaxf(m, mt);
    const float alpha = ex2(m - mn);
    m = mn;
    if (__any(alpha != 1.f)) {
        l *= alpha;
#pragma unroll
        for (int i = 0; i < 16; ++i) { o[0][i] *= alpha; o[1][i] *= alpha; }
    }
    float s = 0.f;
#pragma unroll
    for (int i = 0; i < 16; ++i) { x[i] = ex2(x[i] - mn); s += x[i]; }
    l += s;
    u32x4 w0, w1;
    w0.x = pk(x[0], x[1]); w0.y = pk(x[2], x[3]); w0.z = pk(x[4], x[5]); w0.w = pk(x[6], x[7]);
    w1.x = pk(x[8], x[9]); w1.y = pk(x[10], x[11]); w1.z = pk(x[12], x[13]); w1.w = pk(x[14], x[15]);
    pb[0] = __builtin_bit_cast(bf16x8, w0); pb[1] = __builtin_bit_cast(bf16x8, w1);
}

template <int TYPE>
__device__ __forceinline__ void unit(const Params& P, ATT_LAS unsigned char* lds, int b, int qslot, int kslot, int vslot, int q_tok0, int t0, int nt, int ocol, int bhead) {
    int tid_ = threadIdx.x; asm volatile("" : "+v"(tid_));
    const int tid = tid_, lane = tid & 63, r = lane & 31, h = lane >> 5, wid = __builtin_amdgcn_readfirstlane(tid >> 6);
    const bf16_t* Qp = P.QKV + ((size_t)(b * NSLOT + qslot) * ST + q_tok0 + wid * 32 + r) * 64;
    const bf16_t* Kp = P.QKV + (size_t)(b * NSLOT + kslot) * ST * 64;
    const bf16_t* Vp = P.QKV + (size_t)(b * NSLOT + vslot) * ST * 64;
    bf16x8 qf[4];
#pragma unroll
    for (int ds = 0; ds < 4; ++ds) qf[ds] = *(const bf16x8*)(Qp + 16 * ds + 8 * h);
    int kr0 = 0, nb = 0, qr = 0, qc = 0, rsw = 0, cs = 0;
    ATT_LAS float* rpbl = (ATT_LAS float*)(lds + LDS_RPB);
    if (TYPE == 2) {
        const int R0 = q_tok0 >> 6;
        const int rsa = min(max(R0 - 4, 0), 56), rsb = min(max(R0 + 3 - 4, 0), 56);
        kr0 = rsa; nb = rsb + 8 - rsa; nt = nb + 4;
        qr = R0 + (wid >> 1); qc = 32 * (wid & 1) + r;
        rsw = min(max(qr - 4, 0), 56); cs = min(max(qc - 8, 0), 48);
        for (int i = tid; i < 465; i += 512) rpbl[i] = P.rpb[bhead * 465 + i] * 1.4426950408889634f;
    }
    const int kkey = tid >> 3, kch = tid & 7;
    const int vkey = tid & 63, vch = tid >> 6;
#define ATT_KEY_BASE(j) ((TYPE == 2) ? (((j) < nb) ? 64 * (kr0 + (j)) : SEQ + 64 * ((j) - nb)) : 64 * (t0 + (j)))
    u32x4 kreg, vreg;
    { const int kb = ATT_KEY_BASE(0); kreg = *(const u32x4*)(Kp + (size_t)(kb + kkey) * 64 + 8 * kch); vreg = *(const u32x4*)(Vp + (size_t)(kb + vkey) * 64 + 8 * vch); }
    float m1 = -1e30f, l1 = 0.f, m2 = -1e30f, l2 = 0.f;
    f32x16 o1[2], o2[2];
#pragma unroll
    for (int i = 0; i < 16; ++i) { o1[0][i] = 0.f; o1[1][i] = 0.f; o2[0][i] = 0.f; o2[1][i] = 0.f; }
    const int prow = (r & ~12) | ((r & 4) << 1) | ((r & 8) >> 1);
    for (int j = 0; j < nt; ++j) {
        ATT_LAS unsigned char* Ks = lds + (j & 1) * STAGE_B;
        ATT_LAS unsigned char* Vs = Ks + TILE_B;
        *(ATT_LAS u32x4*)(Ks + kkey * RS + kch * 16) = kreg;
        {
            ATT_LAS unsigned short* vd = (ATT_LAS unsigned short*)(Vs + (8 * vch) * RS + vkey * 2);
            vd[0 * (RS / 2)] = (unsigned short)(vreg.x & 0xffffu); vd[1 * (RS / 2)] = (unsigned short)(vreg.x >> 16);
            vd[2 * (RS / 2)] = (unsigned short)(vreg.y & 0xffffu); vd[3 * (RS / 2)] = (unsigned short)(vreg.y >> 16);
            vd[4 * (RS / 2)] = (unsigned short)(vreg.z & 0xffffu); vd[5 * (RS / 2)] = (unsigned short)(vreg.z >> 16);
            vd[6 * (RS / 2)] = (unsigned short)(vreg.w & 0xffffu); vd[7 * (RS / 2)] = (unsigned short)(vreg.w >> 16);
        }
        __syncthreads();
        if (j + 1 < nt) { const int kb = ATT_KEY_BASE(j + 1); kreg = *(const u32x4*)(Kp + (size_t)(kb + kkey) * 64 + 8 * kch); vreg = *(const u32x4*)(Vp + (size_t)(kb + vkey) * 64 + 8 * vch); }
        bool active = true; int kr = 0;
        if (TYPE == 2 && j < nb) { kr = kr0 + j; active = (kr >= rsw) && (kr < rsw + 8); }
        if (active) {
#pragma unroll 1
            for (int kt = 0; kt < 2; ++kt) {
                bf16x8 kf[4];
#pragma unroll
                for (int ds = 0; ds < 4; ++ds) kf[ds] = *(const ATT_LAS bf16x8*)(Ks + (32 * kt + prow) * RS + (16 * ds + 8 * h) * 2);
                bf16x8 vf[2][2];
#pragma unroll
                for (int dt = 0; dt < 2; ++dt)
#pragma unroll
                    for (int s = 0; s < 2; ++s) vf[dt][s] = *(const ATT_LAS bf16x8*)(Vs + (32 * dt + r) * RS + (32 * kt + 16 * s + 8 * h) * 2);
                f32x16 z;
#pragma unroll
                for (int i = 0; i < 16; ++i) z[i] = 0.f;
                if (TYPE == 1) {
                    f32x16 x1 = MFMA32(kf[0], qf[0], z); x1 = MFMA32(kf[1], qf[1], x1);
                    f32x16 x2 = MFMA32(kf[2], qf[2], z); x2 = MFMA32(kf[3], qf[3], x2);
                    bf16x8 pb[2];
                    softmax_step(x1, m1, l1, o1, pb);
#pragma unroll
                    for (int s = 0; s < 2; ++s) { o1[0] = MFMA32(vf[0][s], pb[s], o1[0]); o1[1] = MFMA32(vf[1][s], pb[s], o1[1]); }
                    softmax_step(x2, m2, l2, o2, pb);
#pragma unroll
                    for (int s = 0; s < 2; ++s) { o2[0] = MFMA32(vf[0][s], pb[s], o2[0]); o2[1] = MFMA32(vf[1][s], pb[s], o2[1]); }
                } else {
                    f32x16 x = MFMA32(kf[0], qf[0], z); x = MFMA32(kf[1], qf[1], x); x = MFMA32(kf[2], qf[2], x); x = MFMA32(kf[3], qf[3], x);
                    if (TYPE == 2 && j < nb) {
                        const int brow = (kr - qr + 7) * 31;
#pragma unroll
                        for (int i = 0; i < 16; ++i) { const int kc = 32 * kt + 16 * (i >> 3) + 8 * h + (i & 7);
                            const bool ok = (kc >= cs) && (kc < cs + 16);
                            const int bi = ok ? (brow + kc - qc + 15) : 0;
                            const float bv = rpbl[bi];
                            x[i] = ok ? x[i] + bv : -INFINITY; }
                    }
                    bf16x8 pb[2];
                    softmax_step(x, m1, l1, o1, pb);
#pragma unroll
                    for (int s = 0; s < 2; ++s) { o1[0] = MFMA32(vf[0][s], pb[s], o1[0]); o1[1] = MFMA32(vf[1][s], pb[s], o1[1]); }
                }
            }
        }
    }
    l1 += __shfl_xor(l1, 32);
    const float inv1 = 1.f / l1;
    f32x16 ov[2];
    if (TYPE == 1) {
        l2 += __shfl_xor(l2, 32);
        const float inv2 = P.lam / l2;
        float ss = 0.f;
#pragma unroll
        for (int dt = 0; dt < 2; ++dt)
#pragma unroll
            for (int i = 0; i < 16; ++i) { const float v = o1[dt][i] * inv1 - o2[dt][i] * inv2; ov[dt][i] = v; ss += v * v; }
        ss += __shfl_xor(ss, 32);
        const float rs = rsqrtf(ss * (1.f / 64.f) + 1e-6f) * P.one_m_lam_init;
#pragma unroll
        for (int dt = 0; dt < 2; ++dt)
#pragma unroll
            for (int i = 0; i < 16; ++i) ov[dt][i] = ov[dt][i] * rs * P.gsub[32 * dt + 8 * (i >> 2) + 4 * h + (i & 3)];
    } else {
#pragma unroll
        for (int dt = 0; dt < 2; ++dt)
#pragma unroll
            for (int i = 0; i < 16; ++i) ov[dt][i] = o1[dt][i] * inv1;
    }
    const int qtok = q_tok0 + wid * 32 + r;
    const size_t orow = (q_tok0 < SEQ) ? (size_t)b * SEQ + qtok : (size_t)LAT_ROWS + (size_t)b * 256 + (qtok - SEQ);
    bf16_t* op = P.O + orow * 1024 + ocol + 4 * h;
#pragma unroll
    for (int dt = 0; dt < 2; ++dt)
#pragma unroll
        for (int g = 0; g < 4; ++g) { u32x2 w; w.x = pk(ov[dt][4 * g], ov[dt][4 * g + 1]); w.y = pk(ov[dt][4 * g + 2], ov[dt][4 * g + 3]);
            *(u32x2*)(op + 32 * dt + 8 * g) = w; }
    __syncthreads();
}
}
#define GAS __attribute__((address_space(1)))
#define LAS __attribute__((address_space(3)))
typedef unsigned short bf16;
typedef unsigned v4u __attribute__((ext_vector_type(4)));
typedef float f32x4 __attribute__((ext_vector_type(4)));
typedef short bf16x8 __attribute__((ext_vector_type(8)));
typedef GAS unsigned gu32;
typedef GAS unsigned long long gu64;
#define RLX_AGENT __ATOMIC_RELAXED, __HIP_MEMORY_SCOPE_AGENT
#define LDS_WAIT() asm volatile("s_waitcnt lgkmcnt(0)" ::: "memory")
#define VM_WAIT() asm volatile("s_waitcnt vmcnt(0)" ::: "memory")
__device__ __forceinline__ unsigned long long rt() { return __builtin_amdgcn_s_memrealtime(); }
__device__ __forceinline__ unsigned f2bf(float f) { unsigned u = __builtin_bit_cast(unsigned, f); return (u + 0x7fffu + ((u >> 16) & 1u)) >> 16; }
__device__ __forceinline__ unsigned pk2(float lo, float hi) { return f2bf(lo) | (f2bf(hi) << 16); }

#define XB_TMO      128
#define XB_XCNT(j)  (256  + 64 * (j))
#define XB_XSUB(j)  (1280 + 64 * (j))
#define XB_XGEN(j)  (2304 + 64 * (j))
#define XB_TOP      3328
#define XB_TOPGEN   3392
#define XCD_BAR_WORDS 3456
#define XB_SPIN_CAP (1u << 18)

__device__ __forceinline__ unsigned xb_ld(unsigned* p)              { return __hip_atomic_load(p, __ATOMIC_RELAXED, __HIP_MEMORY_SCOPE_AGENT); }
__device__ __forceinline__ unsigned xb_add(unsigned* p, unsigned v) { return __hip_atomic_fetch_add(p, v, __ATOMIC_RELAXED, __HIP_MEMORY_SCOPE_AGENT); }
__device__ __forceinline__ unsigned xb_xcc_id() { return (unsigned)__builtin_amdgcn_s_getreg((3 << 11) | 20) & 0xFu; }
#define XB_SPIN(cond, bar) do { unsigned _sp = 0; while (cond) { __builtin_amdgcn_s_sleep(1); \
    if ((++_sp & 255u) == 0u) { if (xb_ld(&(bar)[XB_TMO])) break; if (_sp > XB_SPIN_CAP) { atomicAdd(&(bar)[XB_TMO], 1u); break; } } } } while (0)

struct XcdBarrier {
    unsigned* bar; unsigned x;
    volatile LAS unsigned* st;
};

__device__ __forceinline__ XcdBarrier xcd_barrier_post(unsigned* bar, volatile LAS unsigned* st) {
    XcdBarrier b; b.bar = bar; b.x = xb_xcc_id(); b.st = st;
    if (threadIdx.x == 0) (void)xb_add(&bar[XB_XCNT(b.x)], 1u);
    return b;
}
__device__ __forceinline__ void xcd_barrier_complete(unsigned* bar, unsigned x, unsigned& nloc, unsigned& nx) {
    const unsigned G = gridDim.x * gridDim.y * gridDim.z;
    unsigned sum, cnt, mine, sp = 0u;
    for (;;) {
        sum = 0u; cnt = 0u; mine = 0u;
#pragma unroll
        for (unsigned j = 0; j < 16; ++j) { const unsigned c = xb_ld(&bar[XB_XCNT(j)]); sum += c; cnt += (c > 0u) ? 1u : 0u; mine = (j == x) ? c : mine; }
        if (sum == G) break;
        __builtin_amdgcn_s_sleep(1);
        if ((++sp & 255u) == 0u) { if (xb_ld(&bar[XB_TMO])) break; if (sp > XB_SPIN_CAP) { atomicAdd(&bar[XB_TMO], 1u); break; } }
    }
    nloc = mine > 0u ? mine : 1u; nx = cnt > 0u ? cnt : 1u;
}

__device__ __forceinline__ void xcd_barrier(const XcdBarrier& b) {
    asm volatile("s_waitcnt vmcnt(0)" ::: "memory");
    __syncthreads();
    if (threadIdx.x == 0) {
        unsigned* bar = b.bar;
        __builtin_amdgcn_s_waitcnt(0);
        unsigned nloc = b.st[0], nx = b.st[1];
        if (nloc == 0u) { xcd_barrier_complete(bar, b.x, nloc, nx); b.st[0] = nloc; b.st[1] = nx; }
        const unsigned old = xb_add(&bar[XB_XSUB(b.x)], 1u);
        const unsigned gen = old / nloc;
        if (old + 1u == (gen + 1u) * nloc) {
            __builtin_amdgcn_fence(__ATOMIC_RELEASE, "agent");
            asm volatile("s_waitcnt vmcnt(0)" ::: "memory");
            const unsigned og = xb_add(&bar[XB_TOP], 1u);
            const unsigned tg = og / nx;
            if (og + 1u == (tg + 1u) * nx) xb_add(&bar[XB_TOPGEN], 1u);
            else XB_SPIN(xb_ld(&bar[XB_TOPGEN]) == tg, bar);
            __builtin_amdgcn_fence(__ATOMIC_ACQUIRE, "agent");
            xb_add(&bar[XB_XGEN(b.x)], 1u);
            asm volatile("s_waitcnt vmcnt(0)" ::: "memory");
        } else {
            XB_SPIN(xb_ld(&bar[XB_XGEN(b.x)]) == gen, bar);
            __builtin_amdgcn_fence(__ATOMIC_ACQUIRE, "agent");
            asm volatile("s_waitcnt vmcnt(0)" ::: "memory");
        }
    }
    __syncthreads();
}
constexpr int NWAVES = 8, NTHREADS = 512;
constexpr int BATCH = 8, SEQ = 4096, DM = 1024, CTXL = 256, ST = SEQ + CTXL, FFN = 2816, UGC = 2 * FFN, INC = 2304, NSLOT = 36;
constexpr int LAT_ROWS = BATCH * SEQ, CTX_ROWS = BATCH * CTXL, MROWS = LAT_ROWS + CTX_ROWS;
constexpr float EPS = 1e-6f;
constexpr size_t MiB = 1u << 20;
constexpr size_t WS_CTL = 0, CTL_ZERO_BYTES = 1 * MiB;
constexpr size_t WS_MOD = 1 * MiB;
constexpr size_t WS_TAB = 1 * MiB + 512 * 1024;
constexpr size_t WS_W = 2 * MiB, W_LAYER = 23 * MiB, W_IN = 0, W_OUT = 4 * MiB + 512 * 1024, W_UP = 6 * MiB + 512 * 1024, W_DN = 17 * MiB + 512 * 1024;
constexpr size_t WS_XC = 48 * MiB;
constexpr size_t WS_XN = 56 * MiB;
constexpr size_t WS_QKV = 124 * MiB;
constexpr size_t WS_UG = 124 * MiB;
constexpr size_t WS_ACT = 322 * MiB;
constexpr size_t WS_END = 421 * MiB;
static_assert(WS_QKV + (size_t)BATCH * NSLOT * ST * 64 * 2 <= WS_ACT && WS_UG + (size_t)18432 * UGC * 2 <= WS_ACT && WS_ACT + (size_t)18432 * FFN * 2 <= WS_END, "ws map");
static_assert(WS_XN + (size_t)MROWS * DM * 2 <= WS_QKV && WS_W + 2 * W_LAYER <= WS_XC, "ws map 2");
constexpr int CW_BAR = 4096;
constexpr int LDS_BYTES = 147456, MISC_OFF = 131072 + 320;
constexpr int P0_SCR = 8704, P0_SILU = 73728;
#ifndef PH_G1
#define PH_G1 1
#endif
#ifndef PH_AT
#define PH_AT 1
#endif
#ifndef PH_G2
#define PH_G2 1
#endif
#ifndef PH_G3
#define PH_G3 1
#endif
#ifndef PH_G4
#define PH_G4 1
#endif


__device__ __forceinline__ float wave_sum(float v) {
#pragma unroll
    for (int o = 1; o < 64; o <<= 1) v += __shfl_xor(v, o);
    return v;
}
__device__ __forceinline__ void p0_transpose_item(const float* W, int K, int N, bf16* WT, LAS float* scr, int kb, int n0, int dn0, int lane) {
    const int k0 = 64 * kb;
#pragma unroll 8
    for (int i = 0; i < 32; ++i) { const int kk = 2 * i + (lane >> 5); scr[kk * 33 + (lane & 31)] = W[(size_t)(k0 + kk) * N + n0 + (lane & 31)]; }
    LDS_WAIT(); asm volatile("" ::: "memory");
    const int c = lane & 7;
#pragma unroll
    for (int j = 0; j < 4; ++j) { const int n = (lane >> 3) + 8 * j; const LAS float* s = scr + (8 * c) * 33 + n;
        v4u o; o.x = pk2(s[0 * 33], s[1 * 33]); o.y = pk2(s[2 * 33], s[3 * 33]); o.z = pk2(s[4 * 33], s[5 * 33]); o.w = pk2(s[6 * 33], s[7 * 33]);
        *(GAS v4u*)(WT + (size_t)(dn0 + n) * K + k0 + 8 * c) = o; }
    LDS_WAIT(); asm volatile("" ::: "memory");
}
struct Args { const float* in[26]; float* out; unsigned char* ws; };

__device__ __forceinline__ void norm_phase(const float* src_lat, const float* src_ctx, const float* g, const float* mod, int sh_off, int sc_off, bf16* XN, int nrows, int gw, int NGW, int lane) {
    f32x4 gv[4];
#pragma unroll
    for (int j = 0; j < 4; ++j) gv[j] = *(const f32x4*)(g + 4 * lane + 256 * j);
    for (int m = gw; m < nrows; m += NGW) {
        const bool lat = m < LAT_ROWS;
        const float* xr = lat ? src_lat + (size_t)m * DM : src_ctx + (size_t)(m - LAT_ROWS) * DM;
        const float* mr = mod + (size_t)(lat ? (m >> 12) : 8) * 6144;
        f32x4 v[4]; float s = 0.f;
#pragma unroll
        for (int j = 0; j < 4; ++j) { v[j] = *(const f32x4*)(xr + 4 * lane + 256 * j); s += (v[j].x * v[j].x + v[j].y * v[j].y) + (v[j].z * v[j].z + v[j].w * v[j].w); }
        const float rstd = rsqrtf(wave_sum(s) * (1.f / DM) + EPS);
        unsigned long long* o8 = (unsigned long long*)(XN + (size_t)m * DM) + lane;
#pragma unroll
        for (int j = 0; j < 4; ++j) { const f32x4 sh = *(const f32x4*)(mr + sh_off + 4 * lane + 256 * j), sc = *(const f32x4*)(mr + sc_off + 4 * lane + 256 * j);
            const f32x4 y = ((v[j] * rstd) * gv[j]) * (sc + 1.0f) + sh;
            o8[64 * j] = (unsigned long long)pk2(y.x, y.y) | ((unsigned long long)pk2(y.z, y.w) << 32); }
    }
}
__device__ __forceinline__ float bf_lo(unsigned w) { return __uint_as_float(w << 16); }
__device__ __forceinline__ float bf_hi(unsigned w) { return __uint_as_float(w & 0xffff0000u); }
__device__ __forceinline__ float silu_f(float x) { return x / (1.f + __expf(-x)); }
__device__ __forceinline__ void conv_phase(const bf16* UG, bf16* ACT, const float* cw, const float* cb, int row0, int nrows, int gtid, int NGT) {
    const int total = nrows * 352;
    for (int it = gtid; it < total; it += NGT) {
        const int rr = it / 352, c8 = (it - rr * 352) * 8, r = row0 + rr;
        const int per = r < LAT_ROWS ? SEQ : CTXL;
        const bool first = (r % per) == 0, last = ((r + 1) % per) == 0;
        float res[8];
#pragma unroll
        for (int half = 0; half < 2; ++half) {
            const int col = half * FFN + c8;
            const bf16* p = UG + (size_t)rr * UGC + col;
            const v4u z = {0u, 0u, 0u, 0u};
            const v4u a = first ? z : *(const v4u*)(p - UGC), bq = *(const v4u*)p, c = last ? z : *(const v4u*)(p + UGC);
            float o[8];
#pragma unroll
            for (int q = 0; q < 2; ++q) {
                const f32x4 w0 = *(const f32x4*)(cw + col + 4 * q), w1 = *(const f32x4*)(cw + UGC + col + 4 * q), w2 = *(const f32x4*)(cw + 2 * UGC + col + 4 * q), bb = *(const f32x4*)(cb + col + 4 * q);
                const unsigned a0 = q ? a.z : a.x, a1 = q ? a.w : a.y, b0 = q ? bq.z : bq.x, b1 = q ? bq.w : bq.y, c0 = q ? c.z : c.x, c1 = q ? c.w : c.y;
                o[4 * q + 0] = bf_lo(a0) * w0.x + bf_lo(b0) * w1.x + bf_lo(c0) * w2.x + bb.x;
                o[4 * q + 1] = bf_hi(a0) * w0.y + bf_hi(b0) * w1.y + bf_hi(c0) * w2.y + bb.y;
                o[4 * q + 2] = bf_lo(a1) * w0.z + bf_lo(b1) * w1.z + bf_lo(c1) * w2.z + bb.z;
                o[4 * q + 3] = bf_hi(a1) * w0.w + bf_hi(b1) * w1.w + bf_hi(c1) * w2.w + bb.w;
            }
            if (half == 0) {
#pragma unroll
                for (int i = 0; i < 8; ++i) res[i] = o[i];
            } else {
#pragma unroll
                for (int i = 0; i < 8; ++i) res[i] = silu_f(o[i]) * res[i];
            }
        }
        v4u w; w.x = pk2(res[0], res[1]); w.y = pk2(res[2], res[3]); w.z = pk2(res[4], res[5]); w.w = pk2(res[6], res[7]);
        *(v4u*)(ACT + (size_t)rr * FFN + c8) = w;
    }
}

typedef const __attribute__((address_space(4))) Args* ArgsP;
#define GET_ARGS() ({ ArgsP _p = (ArgsP)__builtin_amdgcn_kernarg_segment_ptr(); asm volatile("" : "+s"(_p)); _p; })
__global__ void __launch_bounds__(NTHREADS, 2) fwd_megakernel(Args args_unused) {
    extern __shared__ __attribute__((aligned(16))) unsigned char lds_raw[];
    LAS unsigned char* lds = (LAS unsigned char*)lds_raw;
    const int G = gridDim.x, bx = blockIdx.x;
    const int vcu = (G % 8 == 0) ? (bx % 8) * (G / 8) + bx / 8 : bx;
    const int NGW = G * NWAVES;
#define PHASE_IDS() int tid = threadIdx.x; asm volatile("" : "+v"(tid)); const int lane = tid & 63, wave = __builtin_amdgcn_readfirstlane(tid >> 6), gw = vcu * NWAVES + wave; (void)lane; (void)gw
    for (int u = threadIdx.x; u < (LDS_BYTES - 131072) / 4; u += NTHREADS) ((LAS unsigned*)(lds + 131072))[u] = 0u;
    __syncthreads();
    XcdBarrier bar;
    { ArgsP A = GET_ARGS(); bar = xcd_barrier_post((unsigned*)(A->ws + WS_CTL) + CW_BAR, (volatile LAS unsigned*)(lds + MISC_OFF) + 8); }
#define GRID_BAR() xcd_barrier(bar)

    {
        PHASE_IDS();
        ArgsP A = GET_ARGS();
        unsigned char* ws = A->ws;
        LAS float* silu = (LAS float*)(lds + P0_SILU);
        { const float* c_in = A->in[1]; const float* cctx_in = A->in[3];
          for (int i = tid; i < 9 * 1024; i += NTHREADS) { const float v = (i < 8192) ? c_in[i] : cctx_in[i - 8192]; silu[i] = silu_f(v); } }
        __syncthreads();
        if (gw < 768) {
            const int l = gw / 384, col = (gw % 384) * 16 + (lane & 15), kq = lane >> 4;
            const float* wp = A->in[4] + (size_t)l * DM * 6144 + col;
            float* mod = (float*)(ws + WS_MOD);
            float a[9];
#pragma unroll
            for (int r = 0; r < 9; ++r) a[r] = 0.f;
#pragma unroll 8
            for (int k = kq; k < DM; k += 4) { const float w = wp[(size_t)k * 6144];
#pragma unroll
                for (int r = 0; r < 9; ++r) a[r] += silu[r * 1024 + k] * w; }
#pragma unroll
            for (int r = 0; r < 9; ++r) { a[r] += __shfl_xor(a[r], 16); a[r] += __shfl_xor(a[r], 32); }
            if (kq == 0) { const float bb = A->in[5][l * 6144 + col];
#pragma unroll
                for (int r = 0; r < 9; ++r) mod[(size_t)(l * 9 + r) * 6144 + col] = a[r] + bb; }
        }
        if (bx == 0) {
            float* tabA = (float*)(ws + WS_TAB); float* tabC = (float*)(ws + WS_TAB + 8192);
            for (int i = tid; i < 64 * 24; i += NTHREADS) {
                const int pos = i / 24, f = i % 24;
                const float inv = (f < 16) ? exp2f(-(float)(2 * f) * (1.f / 32.f) * 13.287712379549449f) : exp2f(-(float)(2 * (f - 16)) * (1.f / 16.f) * 13.287712379549449f);
                const float ang = (float)pos * inv;
                const double rev = (double)ang * 0.15915494309189535; const float fr = (float)(rev - floor(rev));
                const float cv = __builtin_amdgcn_cosf(fr), sv = __builtin_amdgcn_sinf(fr);
                if (f < 16) { tabA[(pos * 16 + f) * 2] = cv; tabA[(pos * 16 + f) * 2 + 1] = sv; } else { tabC[(pos * 8 + f - 16) * 2] = cv; tabC[(pos * 8 + f - 16) * 2 + 1] = sv; }
            }
        }
        LAS float* scr = (LAS float*)(lds + wave * P0_SCR);
        constexpr int I_IN = 16 * 72, I_OUT = 16 * 32, I_UP = 16 * 176, I_DN = 44 * 32, I_L = I_IN + I_OUT + I_UP + I_DN;
        for (int it = gw; it < 2 * I_L; it += NGW) {
            const int l = it / I_L; int r = it % I_L;
            bf16* wb = (bf16*)(ws + WS_W + (size_t)l * W_LAYER);
            if (r < I_IN) { const int kb = r / 72, nb = r % 72, n0 = nb * 32;
                const int pn = n0 >> 8, wc = (n0 >> 6) & 3, bj = (n0 >> 5) & 1;
                p0_transpose_item(A->in[7] + (size_t)l * DM * INC, DM, INC, (bf16*)((unsigned char*)wb + W_IN), scr, kb, n0, pn * 256 + bj * 128 + wc * 32, lane); continue; }
            r -= I_IN;
            if (r < I_OUT) { const int kb = r / 32, nb = r % 32; p0_transpose_item(A->in[20] + (size_t)l * DM * DM, DM, DM, (bf16*)((unsigned char*)wb + W_OUT), scr, kb, nb * 32, nb * 32, lane); continue; }
            r -= I_OUT;
            if (r < I_UP) { const int kb = r / 176, nb = r % 176; p0_transpose_item(A->in[22] + (size_t)l * DM * UGC, DM, UGC, (bf16*)((unsigned char*)wb + W_UP), scr, kb, nb * 32, nb * 32, lane); continue; }
            r -= I_UP;
            { const int kb = r / 32, nb = r % 32; p0_transpose_item(A->in[25] + (size_t)l * FFN * DM, FFN, DM, (bf16*)((unsigned char*)wb + W_DN), scr, kb, nb * 32, nb * 32, lane); }
        }
    }
    GRID_BAR();
    cg::this_grid().sync();


    for (int l = 0; l < 2; ++l) {
        const bool with_ctx = (l == 0);
        const int mrows = with_ctx ? MROWS : LAT_ROWS;
        { PHASE_IDS(); ArgsP A = GET_ARGS(); unsigned char* ws = A->ws;
          norm_phase((l == 0) ? A->in[0] : A->out, (l == 0) ? A->in[2] : (const float*)(ws + WS_XC), A->in[6] + l * DM, (const float*)(ws + WS_MOD) + (size_t)l * 9 * 6144, 0, 1024, (bf16*)(ws + WS_XN), MROWS, gw, NGW, lane); }
        GRID_BAR();
        if (PH_G1) {
            ArgsP A = GET_ARGS(); unsigned char* ws = A->ws;
            pg8::Gemm g{(const bf16*)(ws + WS_XN), (const bf16*)(ws + WS_W + (size_t)l * W_LAYER + W_IN), MROWS, INC, DM}; pg8::StaticOrder S; S.init(MROWS, INC, G, bx);
            pg8::EpiQKV E{(pg8::QkvArgsP)A, l, (unsigned)WS_QKV, (unsigned)WS_TAB};
            pg8::gemm_phase<pg8::EpiQKV, pg8::StaticOrder, true, true>(lds, g, S, E);
        }
        GRID_BAR();
        if (PH_AT) {
            ArgsP A = GET_ARGS(); unsigned char* ws = A->ws;
            const float lam_init = (l == 0) ? 0.2f : 0.35550906759096946f;
            float d1, d2;
            { const int li = (int)(threadIdx.x & 31u);
              d1 = wave_sum(A->in[15][l * 32 + li] * A->in[16][l * 32 + li]) * 0.5f; d2 = wave_sum(A->in[17][l * 32 + li] * A->in[18][l * 32 + li]) * 0.5f; }
            att::Params P{(const bf16*)(ws + WS_QKV), (bf16*)(ws + WS_XN), A->in[12] + (size_t)l * 4 * 465, A->in[19] + l * 64, expf(d1) - expf(d2) + lam_init, 1.f - lam_init};
            for (int u = vcu; u < 1024; u += G) { const int b = u >> 7, hq = (u >> 4) & 7, qb = u & 15;
                att::unit<0>(P, lds, b, hq, 8 + (hq >> 2), 10 + (hq >> 2), qb * 256, 0, 68, hq * 64, 0); }
            for (int u = vcu; u < 512; u += G) { const int b = u >> 6, hc = (u >> 4) & 3, qb = u & 15;
                att::unit<1>(P, lds, b, 24 + hc, 28 + hc, 32 + hc, qb * 256, 0, 68, 768 + hc * 64, 0); }
            for (int u = vcu; u < 512; u += G) { const int b = u >> 6, hb = (u >> 4) & 3, qb = u & 15;
                att::unit<2>(P, lds, b, 12 + hb, 16 + hb, 20 + hb, qb * 256, 0, 0, 512 + hb * 64, hb); }
            if (with_ctx) for (int u = vcu; u < 128; u += G) { const int b = u >> 4, hh = u & 15;
                if (hh < 12) { const int qs = hh < 8 ? hh : 12 + (hh - 8), ks = hh < 8 ? 8 + (hh >> 2) : 16 + (hh - 8), vs = hh < 8 ? 10 + (hh >> 2) : 20 + (hh - 8), oc = hh < 8 ? hh * 64 : 512 + (hh - 8) * 64;
                    att::unit<0>(P, lds, b, qs, ks, vs, SEQ, 64, 4, oc, 0); }
                else att::unit<1>(P, lds, b, 24 + (hh - 12), 28 + (hh - 12), 32 + (hh - 12), SEQ, 64, 4, 768 + (hh - 12) * 64, 0); }
        }
        GRID_BAR();
        if (PH_G2) {
            ArgsP A = GET_ARGS(); unsigned char* ws = A->ws;
            pg8::Gemm g{(const bf16*)(ws + WS_XN), (const bf16*)(ws + WS_W + (size_t)l * W_LAYER + W_OUT), mrows, DM, DM}; pg8::StaticOrder S; S.init(mrows, DM, G, bx);
            pg8::EpiGateRes E{(l == 0) ? A->in[0] : A->out, (l == 0) ? A->in[2] : (const float*)(ws + WS_XC), A->out, (float*)(ws + WS_XC), (const float*)(ws + WS_MOD) + (size_t)l * 9 * 6144 + 2048, 6144, 0};
            pg8::gemm_phase<pg8::EpiGateRes, pg8::StaticOrder, true, true>(lds, g, S, E);
        }
        GRID_BAR();
        { PHASE_IDS(); ArgsP A = GET_ARGS(); unsigned char* ws = A->ws;
          norm_phase(A->out, (const float*)(ws + WS_XC), A->in[21] + l * DM, (const float*)(ws + WS_MOD) + (size_t)l * 9 * 6144, 3072, 4096, (bf16*)(ws + WS_XN), mrows, gw, NGW, lane); }
        GRID_BAR();

        for (int ch = 0; ch < 2; ++ch) {
            const int row0 = ch * 16384, nrows = (ch == 0) ? 16384 : mrows - 16384;
            if (PH_G3) {
                ArgsP A = GET_ARGS(); unsigned char* ws = A->ws;
                pg8::Gemm g{(const bf16*)(ws + WS_XN) + (size_t)row0 * DM, (const bf16*)(ws + WS_W + (size_t)l * W_LAYER + W_UP), nrows, UGC, DM}; pg8::StaticOrder S; S.init(nrows, UGC, G, bx);
                pg8::EpiBf16<0> E{(bf16*)(ws + WS_UG), UGC, nullptr, 0, 0, 1.f};
                pg8::gemm_phase<pg8::EpiBf16<0>, pg8::StaticOrder, true, true>(lds, g, S, E);
            }
            GRID_BAR();
            { PHASE_IDS(); ArgsP A = GET_ARGS(); unsigned char* ws = A->ws;
              conv_phase((const bf16*)(ws + WS_UG), (bf16*)(ws + WS_ACT), A->in[23] + (size_t)l * 3 * UGC, A->in[24] + (size_t)l * UGC, row0, nrows, vcu * NTHREADS + tid, G * NTHREADS); }
            GRID_BAR();
            if (PH_G4) {
                ArgsP A = GET_ARGS(); unsigned char* ws = A->ws;
                pg8::Gemm g{(const bf16*)(ws + WS_ACT), (const bf16*)(ws + WS_W + (size_t)l * W_LAYER + W_DN), nrows, DM, FFN}; pg8::StaticOrder S; S.init(nrows, DM, G, bx);
                pg8::EpiGateRes E{A->out, (const float*)(ws + WS_XC), A->out, (float*)(ws + WS_XC), (const float*)(ws + WS_MOD) + (size_t)l * 9 * 6144 + 5120, 6144, row0};
                pg8::gemm_phase<pg8::EpiGateRes, pg8::StaticOrder, true, true>(lds, g, S, E);
            }
            if (!(l == 1 && ch == 1)) GRID_BAR();
        }
    }
}

extern "C" void kernel_launch(void* const* d_in, const int* in_sizes, int n_in, void* d_out, int out_size, void* d_ws, size_t ws_size, hipStream_t stream) {
    static int grid = 0;
    if (grid == 0) {
        int dev = 0, cus = 0, per_cu = 0;
        if (n_in != 26 || ws_size < WS_END) { fprintf(stderr, "kernel_launch: unexpected n_in %d / ws %zu\n", n_in, ws_size); grid = -1; return; }
        if (hipGetDevice(&dev) != hipSuccess || hipDeviceGetAttribute(&cus, hipDeviceAttributeMultiprocessorCount, dev) != hipSuccess) { grid = -1; return; }
        if (hipFuncSetAttribute((const void*)fwd_megakernel, hipFuncAttributeMaxDynamicSharedMemorySize, LDS_BYTES) != hipSuccess) { fprintf(stderr, "kernel_launch: hipFuncSetAttribute failed\n"); grid = -1; return; }
        if (hipOccupancyMaxActiveBlocksPerMultiprocessor(&per_cu, (const void*)fwd_megakernel, NTHREADS, LDS_BYTES) != hipSuccess || per_cu < 1) per_cu = 1;
        (void)hipGetLastError();
        grid = cus * per_cu;
    }
    if (grid < 0) return;
    (void)hipMemsetAsync((char*)d_ws + WS_CTL, 0, CTL_ZERO_BYTES, stream);
    Args a{};
    for (int i = 0; i < 26; ++i) a.in[i] = (const float*)d_in[i];
    a.out = (float*)d_out; a.ws = (unsigned char*)d_ws;
    void* kargs[] = {&a};
    hipError_t e = hipLaunchCooperativeKernel((const void*)fwd_megakernel, dim3(grid), dim3(NTHREADS), kargs, LDS_BYTES, stream);
    if (e != hipSuccess) fprintf(stderr, "cooperative launch failed: %s (grid %d)\n", hipGetErrorString(e), grid);
}
```

```cpp
#include <hip/hip_runtime.h>
#include <hip/hip_cooperative_groups.h>
#include <cstdio>
#include <cstdint>
namespace cg = cooperative_groups;
namespace pg8 {
#define PG8_LAS __attribute__((address_space(3)))
typedef unsigned short bf16_t;
typedef short bf16x8 __attribute__((ext_vector_type(8)));
typedef float f32x4 __attribute__((ext_vector_type(4)));
typedef unsigned u32x4 __attribute__((ext_vector_type(4)));
constexpr int BM = 256, BK = 64, HALF = 128, HTB = HALF * BK * 2  , STAGE_BYTES = 8 * HTB, NXCD = 8, WGM = 8;

__host__ __device__ __forceinline__ int lds_byte(int r, int c) { const int st = (r >> 4) * 2 + (c >> 5), rr = r & 15, cc = c & 31, ob = rr * 64 + cc * 2; return st * 1024 + (ob ^ (((ob >> 9) & 1) << 5)); }
__host__ __device__ __forceinline__ void stage_rc(int b, int& R, int& C) { const int st = b / 1024, sb = b % 1024, swz = sb ^ (((sb >> 9) & 1) << 5); R = (st >> 1) * 16 + swz / 64; C = (st & 1) * 32 + (swz % 64) / 2; }
__host__ __device__ __forceinline__ int perm32(int rho) { const int n = rho >> 4, i = rho & 15; return 8 * (i >> 2) + 4 * n + (i & 3); }

struct Unit { int pm, pn; };
struct Gemm { const bf16_t* A; const bf16_t* Bt; int M, N, K; };

struct StaticOrder {
    int nM, nN, nwg, G, c;
    __host__ __device__ void init(int M, int N, int G_, int c_) { nM = M / BM; nN = N / BM; nwg = nM * nN; G = G_; c = c_; }
    __host__ __device__ bool next(int i, Unit& u) const {
        const long L = (long)i * G + c; if (L >= nwg) return false;
        int wgid = (int)L; { const int q = nwg / NXCD, r = nwg % NXCD, xcd = wgid % NXCD, off = wgid / NXCD; wgid = (xcd < r ? xcd * (q + 1) : r * (q + 1) + (xcd - r) * q) + off; }
        const int nig = WGM * nN, gid = wgid / nig, fm = gid * WGM, gsz = (nM - fm) < WGM ? (nM - fm) : WGM;
        u.pm = fm + ((wgid % nig) % gsz); u.pn = (wgid % nig) / gsz; return true;
    }
    __device__ __forceinline__ void a_ready(const Unit&) const {}
    __device__ __forceinline__ void done(const Unit&) const {}
};

__device__ __forceinline__ unsigned cvt_pk_bf16(float lo, float hi) { unsigned r; asm volatile("v_cvt_pk_bf16_f32 %0, %1, %2" : "=v"(r) : "v"(lo), "v"(hi)); return r; }
typedef float f32x2 __attribute__((ext_vector_type(2)));
__device__ __forceinline__ f32x2 gelu_pk(f32x2 v) {
    const f32x2 av = __builtin_elementwise_abs(v), d = av * 0.2316418882f + 1.0f;
    f32x2 t; t.x = __builtin_amdgcn_rcpf(d.x); t.y = __builtin_amdgcn_rcpf(d.y);
    f32x2 q = t * 0.5307027145f + (-0.7265760135f); q = q * t + 0.7107068705f; q = q * t + (-0.142248368f); q = q * t + 0.127414796f; q = q * t;
    const f32x2 s = (v * v) * (-0.72134752044f);
    f32x2 e; e.x = __builtin_amdgcn_exp2f(s.x); e.y = __builtin_amdgcn_exp2f(s.y);
    const f32x2 m = v * (q * e), r = v - m;
    f32x2 o; o.x = v.x < 0.f ? m.x : r.x; o.y = v.y < 0.f ? m.y : r.y; return o;
}

template <int ACT  > struct EpiBf16 {
    static constexpr bool PERM = true, AFTER_DRAIN = false, AMAP = false; static_assert(ACT == 0 || ACT == 1, "EpiBf16: ACT is 0 (none) or 1 (gelu_pk)");
    bf16_t* O; int ldc; const float* bias; int split_cols; size_t split_stride; float scale0;
    __device__ __forceinline__ void operator()(const f32x4 (&acc)[2][2][4][2], const Unit& u, int wr, int wc, int fr, int fq) const {
        const int row0 = u.pm * BM + wr * 64 + fr; int colt = u.pn * BM; bf16_t* base = O;
        float sc = 1.f; if (split_cols) { const int t = colt / split_cols; base += (size_t)t * split_stride; colt -= t * split_cols; if (t == 0) sc = scale0; }
        const int col0 = colt + wc * 32 + 8 * fq, bcol0 = u.pn * BM + wc * 32 + 8 * fq;
        f32x4 bv[2][2];
#pragma unroll
        for (int bj = 0; bj < 2; ++bj)
#pragma unroll
            for (int n = 0; n < 2; ++n) bv[bj][n] = bias ? *(const f32x4*)(bias + bcol0 + bj * HALF + 4 * n) : (f32x4){0.f, 0.f, 0.f, 0.f};
#pragma unroll
        for (int ai = 0; ai < 2; ++ai)
#pragma unroll
            for (int m = 0; m < 4; ++m) { bf16_t* rowp = base + (size_t)(row0 + ai * HALF + m * 16) * ldc + col0;
#pragma unroll
                for (int bj = 0; bj < 2; ++bj) { f32x4 v0 = acc[ai][bj][m][0] + bv[bj][0], v1 = acc[ai][bj][m][1] + bv[bj][1];
                    if (ACT == 1) { f32x2 a = gelu_pk((f32x2){v0[0], v0[1]}), b = gelu_pk((f32x2){v0[2], v0[3]}), c = gelu_pk((f32x2){v1[0], v1[1]}), d = gelu_pk((f32x2){v1[2], v1[3]});
                        v0 = (f32x4){a.x, a.y, b.x, b.y}; v1 = (f32x4){c.x, c.y, d.x, d.y}; }
                    v0 = v0 * sc; v1 = v1 * sc; u32x4 w; w.x = cvt_pk_bf16(v0[0], v0[1]); w.y = cvt_pk_bf16(v0[2], v0[3]); w.z = cvt_pk_bf16(v1[0], v1[1]); w.w = cvt_pk_bf16(v1[2], v1[3]);
                    *(u32x4*)(rowp + bj * HALF) = w; } }
    }
};
constexpr int P_S = 4096, P_CTX = 256, P_ST = 4352, P_NSLOT = 36, P_LAT_ROWS = 32768;
constexpr float P_EPS = 1e-6f, P_LOG2E = 1.4426950408889634f;
typedef float f32x2e __attribute__((ext_vector_type(2)));
struct QkvArgs { const float* in[26]; float* out; unsigned char* ws; };
typedef const __attribute__((address_space(4))) QkvArgs* QkvArgsP;
struct EpiQKV {
    static constexpr bool PERM = true, AFTER_DRAIN = false, AMAP = false;
    QkvArgsP A; int l; unsigned qkv_off; const PG8_LAS float* tabL;
    __device__ __forceinline__ void operator()(const f32x4 (&acc)[2][2][4][2], const Unit& u, int wr, int wc, int fr, int fq) const {
        asm volatile("" : "+v"(fr), "+v"(fq));
        const int slot = u.pn * 4 + wc;
        int b, tok0; const bool lat = u.pm < 128;
        if (lat) { b = u.pm >> 4; tok0 = (u.pm & 15) * 256; } else { b = u.pm - 128; tok0 = P_S; }
        unsigned char* ws = A->ws;
        bf16_t* QKV = (bf16_t*)(ws + qkv_off); const PG8_LAS float* tabA = tabL; const PG8_LAS float* tabC = tabL + 2048;
        const float* g = nullptr; int rope = 0; bool half = false; float qs = 1.f;
        if (slot < 8) { g = A->in[8] + l * 64; rope = 1; qs = 0.125f * P_LOG2E; }
        else if (slot < 10) { g = A->in[9] + l * 64; rope = 1; }
        else if (slot < 12) { }
        else if (slot < 16) { g = A->in[10] + l * 64; qs = 0.125f * P_LOG2E; }
        else if (slot < 20) { g = A->in[11] + l * 64; }
        else if (slot < 24) { }
        else if (slot < 28) { g = A->in[13] + l * 32; rope = 2; half = true; qs = 0.17677669529663687f * P_LOG2E; }
        else if (slot < 32) { g = A->in[14] + l * 32; rope = 2; half = true; }
        if (!lat) rope = 0;
        f32x4 gv[2][2];
#pragma unroll
        for (int bj = 0; bj < 2; ++bj)
#pragma unroll
            for (int n = 0; n < 2; ++n) gv[bj][n] = g ? *(const f32x4*)(g + (half ? 0 : 32 * bj) + 8 * fq + 4 * n) : (f32x4){1.f, 1.f, 1.f, 1.f};
        bf16_t* base = QKV + ((size_t)(b * P_NSLOT + slot) * P_ST + tok0) * 64 + 8 * fq;
#pragma unroll
        for (int ai = 0; ai < 2; ++ai)
#pragma unroll
            for (int m = 0; m < 4; ++m) {
                const int R = ai * HALF + wr * 64 + m * 16 + fr;
                f32x4 v[2][2];
#pragma unroll
                for (int bj = 0; bj < 2; ++bj)
#pragma unroll
                    for (int n = 0; n < 2; ++n) v[bj][n] = acc[ai][bj][m][n];
                if (g) {
                    float ss[2];
#pragma unroll
                    for (int bj = 0; bj < 2; ++bj) { float s = 0.f;
#pragma unroll
                        for (int n = 0; n < 2; ++n) s += (v[bj][n][0] * v[bj][n][0] + v[bj][n][1] * v[bj][n][1]) + (v[bj][n][2] * v[bj][n][2] + v[bj][n][3] * v[bj][n][3]);
                        { const auto q = __builtin_amdgcn_permlane16_swap(__float_as_uint(s), __float_as_uint(s), false, false); s = __uint_as_float(q[0]) + __uint_as_float(q[1]); }
                        { const auto q = __builtin_amdgcn_permlane32_swap(__float_as_uint(s), __float_as_uint(s), false, false); s = __uint_as_float(q[0]) + __uint_as_float(q[1]); }
                        ss[bj] = s; }
                    float rs[2];
                    if (half) { rs[0] = rsqrtf(ss[0] * (1.f / 32.f) + P_EPS); rs[1] = rsqrtf(ss[1] * (1.f / 32.f) + P_EPS); }
                    else { rs[0] = rsqrtf((ss[0] + ss[1]) * (1.f / 64.f) + P_EPS); rs[1] = rs[0]; }
#pragma unroll
                    for (int bj = 0; bj < 2; ++bj)
#pragma unroll
                        for (int n = 0; n < 2; ++n) v[bj][n] = (v[bj][n] * rs[bj]) * gv[bj][n];
                    if (rope) {
                        const int tok = tok0 + R, rowpos = tok >> 6, colpos = tok & 63;
#pragma unroll
                        for (int bj = 0; bj < 2; ++bj) {
                            const PG8_LAS float* tp;
                            if (rope == 1) tp = tabA + ((bj == 0 ? rowpos : colpos) * 16 + 4 * fq) * 2;
                            else tp = tabC + ((fq < 2 ? rowpos : colpos) * 8 + 4 * (fq & 1)) * 2;
                            const f32x4 t0 = *(const PG8_LAS f32x4*)tp, t1 = *(const PG8_LAS f32x4*)(tp + 4);
                            { const f32x4 y = v[bj][0]; v[bj][0] = (f32x4){y[0] * t0[0] - y[1] * t0[1], y[0] * t0[1] + y[1] * t0[0], y[2] * t0[2] - y[3] * t0[3], y[2] * t0[3] + y[3] * t0[2]}; }
                            { const f32x4 y = v[bj][1]; v[bj][1] = (f32x4){y[0] * t1[0] - y[1] * t1[1], y[0] * t1[1] + y[1] * t1[0], y[2] * t1[2] - y[3] * t1[3], y[2] * t1[3] + y[3] * t1[2]}; }
                        }
                    }
                }
                bf16_t* rowp = base + (unsigned)(R * 64);
#pragma unroll
                for (int bj = 0; bj < 2; ++bj) { const f32x4 v0 = v[bj][0] * qs, v1 = v[bj][1] * qs;
                    u32x4 w; w.x = cvt_pk_bf16(v0[0], v0[1]); w.y = cvt_pk_bf16(v0[2], v0[3]); w.z = cvt_pk_bf16(v1[0], v1[1]); w.w = cvt_pk_bf16(v1[2], v1[3]);
                    *(u32x4*)(rowp + 32 * bj) = w; }
                asm volatile("" ::: "memory");
            }
    }
};
struct EpiGateRes {
    static constexpr bool PERM = true, AFTER_DRAIN = false, AMAP = false;
    const float* base_lat; const float* base_ctx; float* out_lat; float* out_ctx; const float* gate; int gate_stride; int row_off;
    __device__ __forceinline__ void operator()(const f32x4 (&acc)[2][2][4][2], const Unit& u, int wr, int wc, int fr, int fq) const {
        asm volatile("" : "+v"(fr), "+v"(fq));
        const int r0 = row_off + u.pm * BM;
        const bool lat = r0 < P_LAT_ROWS;
        const int brow = lat ? (r0 >> 12) : 8;
        const float* bp = lat ? base_lat + (size_t)r0 * 1024 : base_ctx + (size_t)(r0 - P_LAT_ROWS) * 1024;
        float* op = lat ? out_lat + (size_t)r0 * 1024 : out_ctx + (size_t)(r0 - P_LAT_ROWS) * 1024;
        const int col0 = u.pn * BM + wc * 32 + 8 * fq;
        f32x4 gv[2][2];
#pragma unroll
        for (int bj = 0; bj < 2; ++bj)
#pragma unroll
            for (int n = 0; n < 2; ++n) gv[bj][n] = *(const f32x4*)(gate + (size_t)brow * gate_stride + col0 + bj * HALF + 4 * n);
#pragma unroll
        for (int ai = 0; ai < 2; ++ai)
#pragma unroll
            for (int m = 0; m < 4; ++m) { const unsigned off = (unsigned)(ai * HALF + wr * 64 + m * 16 + fr) * 1024u + (unsigned)col0;
#pragma unroll
                for (int bj = 0; bj < 2; ++bj)
#pragma unroll
                    for (int n = 0; n < 2; ++n) { const f32x4 bs = *(const f32x4*)(bp + off + bj * HALF + 4 * n);
                        *(f32x4*)(op + off + bj * HALF + 4 * n) = bs + gv[bj][n] * acc[ai][bj][m][n]; }
                asm volatile("" ::: "memory"); }
    }
};
struct EpiConv {
    static constexpr bool PERM = true, AFTER_DRAIN = false, AMAP = true;
    bf16_t* ACTp; float* SB; const float* cw; const float* cb;
    __device__ __forceinline__ void operator()(const f32x4 (&acc)[2][2][4][2], const Unit& u, int wr, int wc, int fr, int fq) const {
        asm volatile("" : "+v"(fr), "+v"(fq));
        typedef unsigned u32x2c __attribute__((ext_vector_type(2)));
        const int j0 = u.pn * 128 + wc * 32 + 8 * fq, rowbase = u.pm * BM;
        u32x2c keep[2][4];
#pragma unroll
        for (int n = 0; n < 2; ++n) {
            const int j = j0 + 4 * n;
            const f32x4 wu0 = *(const f32x4*)(cw + j), wu1 = *(const f32x4*)(cw + 5632 + j), wu2 = *(const f32x4*)(cw + 2 * 5632 + j), bu = *(const f32x4*)(cb + j);
            const f32x4 wg0 = *(const f32x4*)(cw + 2816 + j), wg1 = *(const f32x4*)(cw + 5632 + 2816 + j), wg2 = *(const f32x4*)(cw + 2 * 5632 + 2816 + j), bg = *(const f32x4*)(cb + 2816 + j);
#pragma unroll
            for (int ai = 0; ai < 2; ++ai) {
                const int row0 = rowbase + ai * HALF + wr * 64, seg = row0 >> 6;
                f32x4 Up, Un, Gp, Gn;
#pragma unroll
                for (int c = 0; c < 4; ++c) {
                    Up[c] = __int_as_float(__builtin_amdgcn_update_dpp(__float_as_int(acc[ai][0][3][n][c]), __float_as_int(acc[ai][0][3][n][c]), 0x111, 0xf, 0xf, false));
                    Un[c] = __int_as_float(__builtin_amdgcn_update_dpp(__float_as_int(acc[ai][0][0][n][c]), __float_as_int(acc[ai][0][0][n][c]), 0x101, 0xf, 0xf, false));
                    Gp[c] = __int_as_float(__builtin_amdgcn_update_dpp(__float_as_int(acc[ai][1][3][n][c]), __float_as_int(acc[ai][1][3][n][c]), 0x111, 0xf, 0xf, false));
                    Gn[c] = __int_as_float(__builtin_amdgcn_update_dpp(__float_as_int(acc[ai][1][0][n][c]), __float_as_int(acc[ai][1][0][n][c]), 0x101, 0xf, 0xf, false)); }
#pragma unroll
                for (int m = 0; m < 4; ++m) {
                    const f32x4 pu = m ? acc[ai][0][m ? m - 1 : 0][n] : Up, nu = (m < 3) ? acc[ai][0][m < 3 ? m + 1 : 3][n] : Un;
                    const f32x4 pg = m ? acc[ai][1][m ? m - 1 : 0][n] : Gp, ng = (m < 3) ? acc[ai][1][m < 3 ? m + 1 : 3][n] : Gn;
                    const f32x4 cu = pu * wu0 + acc[ai][0][m][n] * wu1 + nu * wu2 + bu;
                    const f32x4 cgv = pg * wg0 + acc[ai][1][m][n] * wg1 + ng * wg2 + bg;
                    f32x4 a;
#pragma unroll
                    for (int c = 0; c < 4; ++c) a[c] = (cgv[c] * cu[c]) * __builtin_amdgcn_rcpf(1.f + __builtin_amdgcn_exp2f(cgv[c] * -1.4426950408889634f));
                    u32x2c w; w.x = cvt_pk_bf16(a[0], a[1]); w.y = cvt_pk_bf16(a[2], a[3]);
                    if (n == 0) keep[ai][m] = w;
                    else { u32x4 w4; w4.x = keep[ai][m].x; w4.y = keep[ai][m].y; w4.z = w.x; w4.w = w.y;
                        *(u32x4*)(ACTp + (size_t)(row0 + 4 * fr + m) * 2816 + j0) = w4; }
                }
                if (fr == 0) { float* s = SB + (size_t)(seg * 4) * 5632 + j;
                    *(f32x4*)(s) = acc[ai][0][0][n]; *(f32x4*)(s + 2816) = acc[ai][1][0][n]; *(f32x4*)(s + 5632) = acc[ai][0][1][n]; *(f32x4*)(s + 5632 + 2816) = acc[ai][1][1][n]; }
                if (fr == 15) { float* s = SB + (size_t)(seg * 4 + 2) * 5632 + j;
                    *(f32x4*)(s) = acc[ai][0][2][n]; *(f32x4*)(s + 2816) = acc[ai][1][2][n]; *(f32x4*)(s + 5632) = acc[ai][0][3][n]; *(f32x4*)(s + 5632 + 2816) = acc[ai][1][3][n]; }
                asm volatile("" ::: "memory");
            }
        }
    }
};
template <class Epi, class Sched, bool ALIGN_EPI = false, bool SP2 = false>
__device__ __forceinline__ void gemm_phase(PG8_LAS unsigned char* lds, const Gemm g, const Sched& S, const Epi& E) {
    int tid_ = threadIdx.x; asm volatile("" : "+v"(tid_));
    const int tid = tid_, wid = __builtin_amdgcn_readfirstlane(tid >> 6), lane = tid & 63, wr = wid >> 2, wc = wid & 3, fr = lane & 15, fq = lane >> 4;
    const int K = g.K, nt = K / BK;
    unsigned voffA[2], voffB[2];
#pragma unroll
    for (int i = 0; i < 2; ++i) { int R, C; stage_rc(tid * 16 + i * 8192, R, C); const int Rb = Epi::PERM ? ((R & ~31) + perm32(R & 31)) : R;
        const int Ra = Epi::AMAP ? ((R & 64) | ((R & 15) << 2) | ((R >> 4) & 3)) : R;
        voffA[i] = (unsigned)(Ra * K + C) * 2u; voffB[i] = (unsigned)(Rb * K + C) * 2u; }
    const size_t kstep = (size_t)(BK * 2);
    const size_t hstep = (size_t)HALF * K * 2;
    const size_t tstep = 2 * hstep;
    const unsigned ldsw = (unsigned)wid * 1024u;
    const int aoff = lds_byte(wr * 64 + fr, fq * 8), boff = lds_byte(wc * 32 + fr, fq * 8);
#define PG8_SA(b, h) (((b) * 2 + (h)) * HTB)
#define PG8_SB(b, h) ((4 + (b) * 2 + (h)) * HTB)
#define PG8_STAGE(bufoff, gbase, voff) do { _Pragma("unroll") for (int _i = 0; _i < 2; ++_i) \
        __builtin_amdgcn_global_load_lds((const unsigned*)((const char*)(gbase) + (voff)[_i]), (PG8_LAS unsigned*)(lds + (bufoff) + ldsw + _i * 8192), 16, 0, 0); } while (0)
#define PG8_LDA(dst, b, h) do { _Pragma("unroll") for (int m = 0; m < 4; ++m) _Pragma("unroll") for (int k = 0; k < 2; ++k) dst[m][k] = *(const PG8_LAS bf16x8*)(lds + PG8_SA(b, h) + aoff + m * 2048 + k * 1024); } while (0)
#define PG8_LDB(dst, b, h) do { _Pragma("unroll") for (int n = 0; n < 2; ++n) _Pragma("unroll") for (int k = 0; k < 2; ++k) dst[n][k] = *(const PG8_LAS bf16x8*)(lds + PG8_SB(b, h) + boff + n * 2048 + k * 1024); } while (0)
#define PG8_MMA(ai, bj, At, Bt) do { __builtin_amdgcn_s_setprio(1); _Pragma("unroll") for (int m = 0; m < 4; ++m) _Pragma("unroll") for (int n = 0; n < 2; ++n) _Pragma("unroll") for (int k = 0; k < 2; ++k) \
        acc[ai][bj][m][n] = __builtin_amdgcn_mfma_f32_16x16x32_bf16(Bt[n][k], At[m][k], acc[ai][bj][m][n], 0, 0, 0); __builtin_amdgcn_s_setprio(0); } while (0)
#define PG8_WAIT_V(n) asm volatile("s_waitcnt vmcnt(" #n ")" ::: "memory")
#define PG8_WAIT_L(n) asm volatile("s_waitcnt lgkmcnt(" #n ")" ::: "memory")
#define PG8_BAR __builtin_amdgcn_s_barrier()
#define PG8_SCHED __builtin_amdgcn_sched_barrier(0)
    Unit cur, nxt; int ui = 0;
    if (!S.next(0, cur)) return;
    f32x4 acc[2][2][4][2];
#pragma unroll
    for (int a = 0; a < 2; ++a)
#pragma unroll
        for (int b = 0; b < 2; ++b)
#pragma unroll
            for (int m = 0; m < 4; ++m)
#pragma unroll
                for (int n = 0; n < 2; ++n) acc[a][b][m][n] = (f32x4){0.f, 0.f, 0.f, 0.f};
    bf16x8 At[4][2], B0[2][2], B1[2][2];
    const char* cA = (const char*)g.A + (size_t)cur.pm * tstep; const char* cB = (const char*)g.Bt + (size_t)cur.pn * tstep;
    S.a_ready(cur);
    if constexpr (SP2) {
        PG8_STAGE(PG8_SB(0, 0), cB, voffB); PG8_STAGE(PG8_SB(0, 1), cB + hstep, voffB); PG8_STAGE(PG8_SA(0, 0), cA, voffA); PG8_STAGE(PG8_SA(0, 1), cA + hstep, voffA);
        if (wr == 1) PG8_BAR;
        PG8_WAIT_V(2); PG8_BAR;
        PG8_STAGE(PG8_SB(1, 0), cB + kstep, voffB); PG8_STAGE(PG8_SA(1, 0), cA + kstep, voffA); PG8_STAGE(PG8_SB(1, 1), cB + hstep + kstep, voffB);
        PG8_WAIT_V(6); PG8_BAR;
    } else {
        PG8_STAGE(PG8_SB(0, 0), cB, voffB); PG8_STAGE(PG8_SA(0, 0), cA, voffA); PG8_STAGE(PG8_SB(0, 1), cB + hstep, voffB); PG8_STAGE(PG8_SA(0, 1), cA + hstep, voffA);
        if (wr == 1) PG8_BAR;
        PG8_WAIT_V(4); PG8_BAR;
        PG8_STAGE(PG8_SB(1, 0), cB + kstep, voffB); PG8_STAGE(PG8_SA(1, 0), cA + kstep, voffA); PG8_STAGE(PG8_SB(1, 1), cB + hstep + kstep, voffB);
        PG8_WAIT_V(6); PG8_BAR;
    }
    for (;;) {
        const bool has_next = S.next(ui + 1, nxt);
        const char* nA = has_next ? (const char*)g.A + (size_t)nxt.pm * tstep : cA; const char* nB = has_next ? (const char*)g.Bt + (size_t)nxt.pn * tstep : cB;
        for (int t = 0; t < nt; t += 2) {
            const bool last = (t == nt - 2);
            const char* a1 = cA + (size_t)(t + 1) * kstep;
            const char* a2 = last ? nA : cA + (size_t)(t + 2) * kstep; const char* b2 = last ? nB : cB + (size_t)(t + 2) * kstep;
            const char* a3 = a2 + kstep; const char* b3 = b2 + kstep;
            if (last && has_next) S.a_ready(nxt);
            if constexpr (SP2) {
            PG8_LDB(B0, 0, 0); PG8_LDB(B1, 0, 1); PG8_SCHED; PG8_LDA(At, 0, 0); PG8_STAGE(PG8_SA(1, 1), a1 + hstep, voffA);
            PG8_WAIT_V(8); PG8_WAIT_L(0); PG8_BAR; PG8_MMA(0, 0, At, B0); PG8_MMA(0, 1, At, B1); PG8_BAR; PG8_SCHED;
            PG8_LDA(At, 0, 1); PG8_STAGE(PG8_SB(0, 0), b2, voffB); PG8_STAGE(PG8_SB(0, 1), b2 + hstep, voffB); PG8_STAGE(PG8_SA(0, 0), a2, voffA);
            PG8_WAIT_V(8); PG8_WAIT_L(0); PG8_BAR; PG8_MMA(1, 0, At, B0); PG8_MMA(1, 1, At, B1); PG8_BAR; PG8_SCHED;
            PG8_LDB(B0, 1, 0); PG8_LDB(B1, 1, 1); PG8_SCHED; PG8_LDA(At, 1, 0); PG8_STAGE(PG8_SA(0, 1), a2 + hstep, voffA);
            PG8_WAIT_V(8); PG8_WAIT_L(0); PG8_BAR; PG8_MMA(0, 0, At, B0); PG8_MMA(0, 1, At, B1); PG8_BAR; PG8_SCHED;
            PG8_LDA(At, 1, 1); PG8_STAGE(PG8_SB(1, 0), b3, voffB); PG8_STAGE(PG8_SB(1, 1), b3 + hstep, voffB); PG8_STAGE(PG8_SA(1, 0), a3, voffA);
            PG8_WAIT_V(8); PG8_WAIT_L(0); PG8_BAR; PG8_MMA(1, 0, At, B0); PG8_MMA(1, 1, At, B1); PG8_BAR; PG8_SCHED;
            } else {
            PG8_LDB(B0, 0, 0); PG8_SCHED; PG8_LDA(At, 0, 0); PG8_STAGE(PG8_SA(1, 1), a1 + hstep, voffA);
            PG8_WAIT_L(8); PG8_BAR; PG8_WAIT_L(0); PG8_MMA(0, 0, At, B0); PG8_BAR; PG8_SCHED;
            PG8_LDB(B1, 0, 1); PG8_STAGE(PG8_SB(0, 0), b2, voffB);
            PG8_BAR; PG8_WAIT_L(0); PG8_MMA(0, 1, At, B1); PG8_BAR;
            PG8_LDA(At, 0, 1); PG8_STAGE(PG8_SA(0, 0), a2, voffA);
            PG8_BAR; PG8_WAIT_L(0); PG8_MMA(1, 0, At, B0); PG8_BAR; PG8_SCHED;
            PG8_STAGE(PG8_SB(0, 1), b2 + hstep, voffB);
            PG8_WAIT_V(6); PG8_BAR; PG8_MMA(1, 1, At, B1); PG8_BAR;
            PG8_LDB(B0, 1, 0); PG8_SCHED; PG8_LDA(At, 1, 0); PG8_STAGE(PG8_SA(0, 1), a2 + hstep, voffA);
            PG8_WAIT_L(8); PG8_BAR; PG8_WAIT_L(0); PG8_MMA(0, 0, At, B0); PG8_BAR; PG8_SCHED;
            PG8_LDB(B1, 1, 1); PG8_STAGE(PG8_SB(1, 0), b3, voffB);
            PG8_BAR; PG8_WAIT_L(0); PG8_MMA(0, 1, At, B1); PG8_BAR;
            PG8_LDA(At, 1, 1); PG8_STAGE(PG8_SA(1, 0), a3, voffA);
            PG8_BAR; PG8_WAIT_L(0); PG8_MMA(1, 0, At, B0); PG8_BAR; PG8_SCHED;
            PG8_STAGE(PG8_SB(1, 1), b3 + hstep, voffB);
            PG8_WAIT_V(6); PG8_BAR; PG8_MMA(1, 1, At, B1); PG8_BAR;
            }
        }
        if constexpr (ALIGN_EPI) { if (wr == 0) PG8_BAR; }
        if constexpr (!Epi::AFTER_DRAIN) { E(acc, cur, wr, wc, fr, fq); S.done(cur); }
        if (!has_next) break;
#pragma unroll
        for (int a = 0; a < 2; ++a)
#pragma unroll
            for (int b = 0; b < 2; ++b)
#pragma unroll
                for (int m = 0; m < 4; ++m)
#pragma unroll
                    for (int n = 0; n < 2; ++n) acc[a][b][m][n] = (f32x4){0.f, 0.f, 0.f, 0.f};
        cur = nxt; cA = nA; cB = nB; ++ui;
        if constexpr (ALIGN_EPI) { if (wr == 1) PG8_BAR; }
    }
    PG8_WAIT_V(0);
    if constexpr (!ALIGN_EPI) { if (wr == 0) PG8_BAR; }
    PG8_BAR;
    if constexpr (Epi::AFTER_DRAIN) { E.fused(acc, cur, wr, wc, fr, fq, lds, wid, lane); S.done(cur); }
#undef PG8_SA
#undef PG8_SB
#undef PG8_STAGE
#undef PG8_LDA
#undef PG8_LDB
#undef PG8_MMA
#undef PG8_WAIT_V
#undef PG8_WAIT_L
#undef PG8_BAR
#undef PG8_SCHED
}
}
namespace att {
#define ATT_LAS __attribute__((address_space(3)))
typedef unsigned short bf16_t;
typedef short bf16x8 __attribute__((ext_vector_type(8)));
typedef float f32x16 __attribute__((ext_vector_type(16)));
typedef float f32x2 __attribute__((ext_vector_type(2)));
typedef __bf16 bf16x2v __attribute__((ext_vector_type(2)));
typedef unsigned u32x4 __attribute__((ext_vector_type(4)));
typedef unsigned u32x2 __attribute__((ext_vector_type(2)));
constexpr int ST = 4352, NSLOT = 36, SEQ = 4096, LAT_ROWS = 32768;
constexpr int RS = 144;
constexpr int TILE_B = 64 * RS;
constexpr int KV_B = 2 * TILE_B;
constexpr int STAGE_B = 2 * KV_B;
constexpr int LDS_RPB = 2 * STAGE_B;
constexpr int LDS_BYTES = LDS_RPB + 2048;
constexpr float THR = 8.0f;
#define MFMA32(a, b, c) __builtin_amdgcn_mfma_f32_32x32x16_bf16((a), (b), (c), 0, 0, 0)
__device__ __forceinline__ unsigned pk(float lo, float hi) { f32x2 v = {lo, hi}; bf16x2v b = __builtin_convertvector(v, bf16x2v); return __builtin_bit_cast(unsigned, b); }
__device__ __forceinline__ float ex2(float x) { return __builtin_amdgcn_exp2f(x); }
__device__ __forceinline__ float mx3(float a, float b, float c) { return __builtin_fmaxf(__builtin_fmaxf(a, b), c); }
__device__ __forceinline__ float xsum32(float v) { const auto rr = __builtin_amdgcn_permlane32_swap(__float_as_uint(v), __float_as_uint(v), false, false); return __uint_as_float(rr[0]) + __uint_as_float(rr[1]); }

struct Params { const bf16_t* QKV; bf16_t* O; const float* rpb; const float* gsub; float lam; float one_m_lam_init; };
struct Mask { const ATT_LAS float* rpbl; int brow, cs, qc; };

template <int DS0, int NDS, bool MASK, bool USE_NEGM, bool V_EARLY, int ABL, bool FX = false>
__device__ __forceinline__ void tile_step(const ATT_LAS unsigned char* Ks, const ATT_LAS unsigned char* Vs, const bf16x8 (&qf)[4], int prow, int r, int h,
                                          float& m, float& l, f32x16 (&o)[2], f32x16& negm, bool first, const Mask& mk) {
    bf16x8 ka[NDS], kb[NDS], va[4], vb[4];
#pragma unroll
    for (int d = 0; d < NDS; ++d) {
        ka[d] = *(const ATT_LAS bf16x8*)(Ks + prow * RS + (16 * (DS0 + d) + 8 * h) * 2);
        kb[d] = *(const ATT_LAS bf16x8*)(Ks + (32 + prow) * RS + (16 * (DS0 + d) + 8 * h) * 2);
    }
    if (V_EARLY) {
#pragma unroll
        for (int ks = 0; ks < 4; ++ks) {
            va[ks] = *(const ATT_LAS bf16x8*)(Vs + r * RS + (16 * ks + 8 * h) * 2);
            vb[ks] = *(const ATT_LAS bf16x8*)(Vs + (32 + r) * RS + (16 * ks + 8 * h) * 2);
        }
    }
    f32x16 x0, x1;
    if (ABL == 2) { x0 = negm; x1 = negm; _Pragma("unroll") for (int i = 0; i < 16; ++i) { x0[i] += __builtin_bit_cast(float, (int)ka[0][i & 7]) * 1e-30f; x1[i] += __builtin_bit_cast(float, (int)kb[NDS - 1][i & 7]) * 1e-30f; } } else
    if (USE_NEGM) { x0 = MFMA32(ka[0], qf[DS0], negm); x1 = MFMA32(kb[0], qf[DS0], negm); }
    else { f32x16 z; _Pragma("unroll") for (int i = 0; i < 16; ++i) z[i] = 0.f; x0 = MFMA32(ka[0], qf[DS0], z); x1 = MFMA32(kb[0], qf[DS0], z); }
    if (ABL != 2) {
#pragma unroll
    for (int d = 1; d < NDS; ++d) { x0 = MFMA32(ka[d], qf[DS0 + d], x0); x1 = MFMA32(kb[d], qf[DS0 + d], x1); }
    }
    if (!USE_NEGM && !FX) {
#pragma unroll
        for (int i = 0; i < 16; ++i) { x0[i] -= m; x1[i] -= m; }
    }
    if (MASK) {
        int t = 8 * h - mk.cs, u = mk.brow + 8 * h - mk.qc + 15;
        asm volatile("" : "+v"(t), "+v"(u));
        const ATT_LAS float* bp = mk.rpbl + u;
#pragma unroll
        for (int i = 0; i < 16; ++i) {
            const int c0 = 16 * (i >> 3) + (i & 7);
            const bool ok0 = (unsigned)(c0 + t) < 16u, ok1 = (unsigned)(c0 + 32 + t) < 16u;
            const float b0 = bp[c0], b1 = bp[c0 + 32];
            x0[i] = ok0 ? x0[i] + b0 : -INFINITY; x1[i] = ok1 ? x1[i] + b1 : -INFINITY;
        }
    }
    if (ABL != 1) {
    if (FX) __builtin_amdgcn_sched_barrier(0);
    if (!FX) {
    float ma = mx3(x0[0], x0[1], x1[0]), mb = mx3(x0[2], x0[3], x1[1]);
    ma = mx3(ma, x1[2], x1[3]);
#pragma unroll
    for (int i = 4; i < 16; i += 4) { ma = mx3(ma, x0[i], x0[i + 1]); mb = mx3(mb, x0[i + 2], x0[i + 3]); ma = mx3(ma, x1[i], x1[i + 1]); mb = mx3(mb, x1[i + 2], x1[i + 3]); }
    float mt = __builtin_fmaxf(ma, mb);
    { const auto rr = __builtin_amdgcn_permlane32_swap(__float_as_uint(mt), __float_as_uint(mt), false, false); mt = __builtin_fmaxf(__uint_as_float(rr[0]), __uint_as_float(rr[1])); }
    if (first || __any(mt > THR)) {
        const float dl = first ? mt : __builtin_fmaxf(mt, 0.f);
        m += dl;
#pragma unroll
        for (int i = 0; i < 16; ++i) { x0[i] -= dl; x1[i] -= dl; }
        if (!first) {
            const float f = ex2(-dl);
            l *= f;
#pragma unroll
            for (int i = 0; i < 16; ++i) { o[0][i] *= f; o[1][i] *= f; }
        }
        if (USE_NEGM) {
#pragma unroll
            for (int i = 0; i < 16; ++i) negm[i] = -m;
        }
    }
    }
    if (!V_EARLY) {
#pragma unroll
        for (int ks = 0; ks < 4; ++ks) {
            va[ks] = *(const ATT_LAS bf16x8*)(Vs + r * RS + (16 * ks + 8 * h) * 2);
            vb[ks] = *(const ATT_LAS bf16x8*)(Vs + (32 + r) * RS + (16 * ks + 8 * h) * 2);
        }
    }
    float s0 = 0.f, s1 = 0.f;
#pragma unroll
    for (int i = 0; i < 16; ++i) { x0[i] = ex2(x0[i]); s0 += x0[i]; }
#pragma unroll
    for (int i = 0; i < 16; ++i) { x1[i] = ex2(x1[i]); s1 += x1[i]; }
    l += s0 + s1;
    } else { l += x0[0] + x1[5]; }
    bf16x8 pb[2][2];
    { u32x4 w;
      w.x = pk(x0[0], x0[1]); w.y = pk(x0[2], x0[3]); w.z = pk(x0[4], x0[5]); w.w = pk(x0[6], x0[7]); pb[0][0] = __builtin_bit_cast(bf16x8, w);
      w.x = pk(x0[8], x0[9]); w.y = pk(x0[10], x0[11]); w.z = pk(x0[12], x0[13]); w.w = pk(x0[14], x0[15]); pb[0][1] = __builtin_bit_cast(bf16x8, w);
      w.x = pk(x1[0], x1[1]); w.y = pk(x1[2], x1[3]); w.z = pk(x1[4], x1[5]); w.w = pk(x1[6], x1[7]); pb[1][0] = __builtin_bit_cast(bf16x8, w);
      w.x = pk(x1[8], x1[9]); w.y = pk(x1[10], x1[11]); w.z = pk(x1[12], x1[13]); w.w = pk(x1[14], x1[15]); pb[1][1] = __builtin_bit_cast(bf16x8, w); }
    if (ABL == 2) {
#pragma unroll
        for (int kt = 0; kt < 2; ++kt)
#pragma unroll
            for (int s = 0; s < 2; ++s) { o[0][kt * 2 + s] += __builtin_bit_cast(float, (int)(va[2 * kt + s][0] ^ pb[kt][s][1])); o[1][kt * 2 + s] += __builtin_bit_cast(float, (int)(vb[2 * kt + s][3] ^ pb[kt][s][2])); }
    } else {
#pragma unroll
    for (int kt = 0; kt < 2; ++kt)
#pragma unroll
        for (int s = 0; s < 2; ++s) { o[0] = MFMA32(va[2 * kt + s], pb[kt][s], o[0]); o[1] = MFMA32(vb[2 * kt + s], pb[kt][s], o[1]); }
    }
}

template <int TYPE, int ABL = 0, bool FX = false>
__device__ __forceinline__ void unit(const Params& P, ATT_LAS unsigned char* lds, int b, int qslot, int kslot, int vslot, int q_tok0, int t0, int nt, int ocol, int bhead) {
    int tid_ = threadIdx.x; asm volatile("" : "+v"(tid_));
    const int tid = tid_, lane = tid & 63, r = lane & 31, h = lane >> 5, wid = __builtin_amdgcn_readfirstlane(tid >> 6);
    const bf16_t* Qp = P.QKV + ((size_t)(b * NSLOT + qslot) * ST + q_tok0 + wid * 32 + r) * 64;
    const bf16_t* Kp = P.QKV + (size_t)(b * NSLOT + kslot) * ST * 64;
    const bf16_t* Vp = P.QKV + (size_t)(b * NSLOT + vslot) * ST * 64;
    bf16x8 qf[4];
#pragma unroll
    for (int ds = 0; ds < 4; ++ds) qf[ds] = *(const bf16x8*)(Qp + 16 * ds + 8 * h);
    int kr0 = 0, nb = 0, qr = 0, rsw = 0;
    Mask mk; mk.rpbl = (const ATT_LAS float*)(lds + LDS_RPB); mk.brow = 0; mk.cs = 0; mk.qc = 0;
    if (TYPE == 2) {
        const int R0 = q_tok0 >> 6;
        const int rsa = min(max(R0 - 4, 0), 56), rsb = min(max(R0 + 3 - 4, 0), 56);
        kr0 = rsa; nb = rsb + 8 - rsa; nt = nb + 4;
        qr = R0 + (wid >> 1); mk.qc = 32 * (wid & 1) + r;
        rsw = min(max(qr - 4, 0), 56); mk.cs = min(max(mk.qc - 8, 0), 48);
        ATT_LAS float* rw = (ATT_LAS float*)(lds + LDS_RPB);
        for (int i = tid; i < 465; i += 512) rw[i] = P.rpb[bhead * 465 + i] * 1.4426950408889634f;
    }
    const int kkey = tid >> 3, kch = tid & 7;
    const int vkey = tid & 63, vch = tid >> 6;
#define ATT_KEY_BASE(j) ((TYPE == 2) ? (((j) < nb) ? 64 * (kr0 + (j)) : SEQ + 64 * ((j) - nb)) : 64 * (t0 + (j)))
#define ATT_LOAD(i, j) do { const int kb_ = ATT_KEY_BASE(j); kreg[i] = *(const u32x4*)(Kp + (size_t)(kb_ + kkey) * 64 + 8 * kch); vreg[i] = *(const u32x4*)(Vp + (size_t)(kb_ + vkey) * 64 + 8 * vch); } while (0)
    u32x4 kreg[2], vreg[2];
    ATT_LOAD(0, 0); if (1 < nt) ATT_LOAD(1, 1);
    float m1 = 0.f, l1 = 0.f, m2 = 0.f, l2 = 0.f;
    f32x16 o1[2], o2[2], negm1;
#pragma unroll
    for (int i = 0; i < 16; ++i) { o1[0][i] = 0.f; o1[1][i] = 0.f; o2[0][i] = 0.f; o2[1][i] = 0.f; negm1[i] = 0.f; }
    const int prow = (r & ~12) | ((r & 4) << 1) | ((r & 8) >> 1);
    bool first = true;
    for (int jp = 0; jp < nt; jp += 2) {
        ATT_LAS unsigned char* stg = lds + ((jp >> 1) & 1) * STAGE_B;
#pragma unroll
        for (int i = 0; i < 2; ++i) {
            if (ABL != 3 && jp + i < nt) {
                ATT_LAS unsigned char* Ks = stg + i * KV_B; ATT_LAS unsigned char* Vs = Ks + TILE_B;
                *(ATT_LAS u32x4*)(Ks + kkey * RS + kch * 16) = kreg[i];
                ATT_LAS unsigned short* vd = (ATT_LAS unsigned short*)(Vs + (8 * vch) * RS + vkey * 2);
                vd[0 * (RS / 2)] = (unsigned short)(vreg[i].x & 0xffffu); vd[1 * (RS / 2)] = (unsigned short)(vreg[i].x >> 16);
                vd[2 * (RS / 2)] = (unsigned short)(vreg[i].y & 0xffffu); vd[3 * (RS / 2)] = (unsigned short)(vreg[i].y >> 16);
                vd[4 * (RS / 2)] = (unsigned short)(vreg[i].z & 0xffffu); vd[5 * (RS / 2)] = (unsigned short)(vreg[i].z >> 16);
                vd[6 * (RS / 2)] = (unsigned short)(vreg[i].w & 0xffffu); vd[7 * (RS / 2)] = (unsigned short)(vreg[i].w >> 16);
            }
        }
        __syncthreads();
        if (ABL != 4 && jp + 2 < nt) ATT_LOAD(0, jp + 2);
        if (ABL != 4 && jp + 3 < nt) ATT_LOAD(1, jp + 3);
        if (FX && TYPE == 1) {
#pragma unroll 1
        for (int i = 0; i < 2; ++i) {
            const int j = jp + i;
            if (j >= nt) break;
            const ATT_LAS unsigned char* Ks = stg + i * KV_B; const ATT_LAS unsigned char* Vs = Ks + TILE_B;
            if (TYPE == 2) {
                if (j < nb) {
                    const int kr = kr0 + j;
                    if ((kr >= rsw) && (kr < rsw + 8)) { mk.brow = (kr - qr + 7) * 31; tile_step<0, 4, true, false, false, ABL>(Ks, Vs, qf, prow, r, h, m1, l1, o1, negm1, first, mk); first = false; }
                } else { tile_step<0, 4, false, false, false, ABL>(Ks, Vs, qf, prow, r, h, m1, l1, o1, negm1, first, mk); first = false; }
            } else if (TYPE == 1) {
                tile_step<0, 2, false, false, true, ABL, FX>(Ks, Vs, qf, prow, r, h, m1, l1, o1, negm1, first, mk);
                tile_step<2, 2, false, false, true, ABL, FX>(Ks, Vs, qf, prow, r, h, m2, l2, o2, negm1, first, mk);
                first = false;
            } else { tile_step<0, 4, false, !FX, true, ABL, FX>(Ks, Vs, qf, prow, r, h, m1, l1, o1, negm1, first, mk); first = false; }
        }
        } else {
#pragma unroll
        for (int i = 0; i < 2; ++i) {
            const int j = jp + i;
            if (j >= nt) break;
            const ATT_LAS unsigned char* Ks = stg + i * KV_B; const ATT_LAS unsigned char* Vs = Ks + TILE_B;
            if (TYPE == 2) {
                if (j < nb) {
                    const int kr = kr0 + j;
                    if ((kr >= rsw) && (kr < rsw + 8)) { mk.brow = (kr - qr + 7) * 31; tile_step<0, 4, true, false, false, ABL>(Ks, Vs, qf, prow, r, h, m1, l1, o1, negm1, first, mk); first = false; }
                } else { tile_step<0, 4, false, false, false, ABL>(Ks, Vs, qf, prow, r, h, m1, l1, o1, negm1, first, mk); first = false; }
            } else if (TYPE == 1) {
                tile_step<0, 2, false, false, true, ABL, FX>(Ks, Vs, qf, prow, r, h, m1, l1, o1, negm1, first, mk);
                tile_step<2, 2, false, false, true, ABL, FX>(Ks, Vs, qf, prow, r, h, m2, l2, o2, negm1, first, mk);
                first = false;
            } else { tile_step<0, 4, false, !FX, true, ABL, FX>(Ks, Vs, qf, prow, r, h, m1, l1, o1, negm1, first, mk); first = false; }
        }
        }
    }
    l1 = xsum32(l1);
    const float inv1 = 1.f / l1;
    f32x16 ov[2];
    if (TYPE == 1) {
        l2 = xsum32(l2);
        const float inv2 = P.lam / l2;
        float ss = 0.f;
#pragma unroll
        for (int dt = 0; dt < 2; ++dt)
#pragma unroll
            for (int i = 0; i < 16; ++i) { const float v = o1[dt][i] * inv1 - o2[dt][i] * inv2; ov[dt][i] = v; ss += v * v; }
        ss = xsum32(ss);
        const float rs = rsqrtf(ss * (1.f / 64.f) + 1e-6f) * P.one_m_lam_init;
#pragma unroll
        for (int dt = 0; dt < 2; ++dt)
#pragma unroll
            for (int i = 0; i < 16; ++i) ov[dt][i] = ov[dt][i] * rs * P.gsub[32 * dt + 8 * (i >> 2) + 4 * h + (i & 3)];
    } else {
#pragma unroll
        for (int dt = 0; dt < 2; ++dt)
#pragma unroll
            for (int i = 0; i < 16; ++i) ov[dt][i] = o1[dt][i] * inv1;
    }
    const int qtok = q_tok0 + wid * 32 + r;
    const size_t orow = (q_tok0 < SEQ) ? (size_t)b * SEQ + qtok : (size_t)LAT_ROWS + (size_t)b * 256 + (qtok - SEQ);
    bf16_t* op = P.O + orow * 1024 + ocol + 4 * h;
#pragma unroll
    for (int dt = 0; dt < 2; ++dt)
#pragma unroll
        for (int g = 0; g < 4; ++g) { u32x2 w; w.x = pk(ov[dt][4 * g], ov[dt][4 * g + 1]); w.y = pk(ov[dt][4 * g + 2], ov[dt][4 * g + 3]);
            *(u32x2*)(op + 32 * dt + 8 * g) = w; }
    __syncthreads();
#undef ATT_LOAD
#undef ATT_KEY_BASE
}

template <bool FX>
__device__ __forceinline__ void softmax64(f32x16& x0, f32x16& x1, float& m, float& l, f32x16 (&o)[2], bool first, bf16x8 (&pb)[4]) {
    if (!FX) {
    { float mone = -1.0f; asm volatile("" : "+v"(mone));
#pragma unroll
      for (int i = 0; i < 16; i += 2) { x0[i] -= m; x0[i + 1] = __builtin_fmaf(m, mone, x0[i + 1]); x1[i] = __builtin_fmaf(m, mone, x1[i]); x1[i + 1] -= m; } }
    float ma = mx3(x0[0], x0[1], x1[0]), mb = mx3(x0[2], x0[3], x1[1]);
    ma = mx3(ma, x1[2], x1[3]);
#pragma unroll
    for (int i = 4; i < 16; i += 4) { ma = mx3(ma, x0[i], x0[i + 1]); mb = mx3(mb, x0[i + 2], x0[i + 3]); ma = mx3(ma, x1[i], x1[i + 1]); mb = mx3(mb, x1[i + 2], x1[i + 3]); }
    float mt = __builtin_fmaxf(ma, mb);
    { const auto rr = __builtin_amdgcn_permlane32_swap(__float_as_uint(mt), __float_as_uint(mt), false, false); mt = __builtin_fmaxf(__uint_as_float(rr[0]), __uint_as_float(rr[1])); }
    if (first || __any(mt > THR)) {
        const float dl = first ? mt : __builtin_fmaxf(mt, 0.f);
        m += dl;
#pragma unroll
        for (int i = 0; i < 16; ++i) { x0[i] -= dl; x1[i] -= dl; }
        if (!first) {
            const float f = ex2(-dl);
            l *= f;
#pragma unroll
            for (int i = 0; i < 16; ++i) { o[0][i] *= f; o[1][i] *= f; }
        }
    }
    }
    { float one = 1.0f; asm volatile("" : "+v"(one));
      float sa = 0.f, sb = 0.f;
#pragma unroll
      for (int i = 0; i < 16; ++i) { x0[i] = ex2(x0[i]); x1[i] = ex2(x1[i]); sa += x0[i]; sb = __builtin_fmaf(x1[i], one, sb); }
      l += sa + sb; }
    u32x4 w;
    w.x = pk(x0[0], x0[1]); w.y = pk(x0[2], x0[3]); w.z = pk(x0[4], x0[5]); w.w = pk(x0[6], x0[7]); pb[0] = __builtin_bit_cast(bf16x8, w);
    w.x = pk(x0[8], x0[9]); w.y = pk(x0[10], x0[11]); w.z = pk(x0[12], x0[13]); w.w = pk(x0[14], x0[15]); pb[1] = __builtin_bit_cast(bf16x8, w);
    w.x = pk(x1[0], x1[1]); w.y = pk(x1[2], x1[3]); w.z = pk(x1[4], x1[5]); w.w = pk(x1[6], x1[7]); pb[2] = __builtin_bit_cast(bf16x8, w);
    w.x = pk(x1[8], x1[9]); w.y = pk(x1[10], x1[11]); w.z = pk(x1[12], x1[13]); w.w = pk(x1[14], x1[15]); pb[3] = __builtin_bit_cast(bf16x8, w);
}
template <bool FX>
__device__ __forceinline__ void unit64(const Params& P, ATT_LAS unsigned char* lds, int b, int qslot, int kslot, int vslot, int q_tok0, int nt, int ocol) {
    int tid_ = threadIdx.x; asm volatile("" : "+v"(tid_));
    const int tid = tid_, lane = tid & 63, r = lane & 31, h = lane >> 5, wid = __builtin_amdgcn_readfirstlane(tid >> 6);
    const bf16_t* Qp = P.QKV + ((size_t)(b * NSLOT + qslot) * ST + q_tok0 + wid * 64 + r) * 64;
    const bf16_t* Kp = P.QKV + (size_t)(b * NSLOT + kslot) * ST * 64;
    const bf16_t* Vp = P.QKV + (size_t)(b * NSLOT + vslot) * ST * 64;
    bf16x8 qA[4], qB[4];
#pragma unroll
    for (int ds = 0; ds < 4; ++ds) { qA[ds] = *(const bf16x8*)(Qp + 16 * ds + 8 * h); qB[ds] = *(const bf16x8*)(Qp + 32 * 64 + 16 * ds + 8 * h); }
    const int kkey = tid >> 3, kch = tid & 7, vkey = tid & 63, vch = tid >> 6;
#define U64_LOAD(i, j) do { const int kb_ = 64 * (j); kreg[i] = *(const u32x4*)(Kp + (size_t)(kb_ + kkey) * 64 + 8 * kch); vreg[i] = *(const u32x4*)(Vp + (size_t)(kb_ + vkey) * 64 + 8 * vch); } while (0)
    u32x4 kreg[2], vreg[2];
    U64_LOAD(0, 0); if (1 < nt) U64_LOAD(1, 1);
    float mA = 0.f, lA = 0.f, mB = 0.f, lB = 0.f;
    f32x16 oA[2], oB[2];
#pragma unroll
    for (int i = 0; i < 16; ++i) { oA[0][i] = 0.f; oA[1][i] = 0.f; oB[0][i] = 0.f; oB[1][i] = 0.f; }
    const int prow = (r & ~12) | ((r & 4) << 1) | ((r & 8) >> 1);
    bool first = true;
    for (int jp = 0; jp < nt; jp += 2) {
        ATT_LAS unsigned char* stg = lds + ((jp >> 1) & 1) * STAGE_B;
#pragma unroll
        for (int i = 0; i < 2; ++i) {
            if (jp + i < nt) {
                ATT_LAS unsigned char* Ks = stg + i * KV_B; ATT_LAS unsigned char* Vs = Ks + TILE_B;
                *(ATT_LAS u32x4*)(Ks + kkey * RS + kch * 16) = kreg[i];
                ATT_LAS unsigned short* vd = (ATT_LAS unsigned short*)(Vs + (8 * vch) * RS + vkey * 2);
                vd[0 * (RS / 2)] = (unsigned short)(vreg[i].x & 0xffffu); vd[1 * (RS / 2)] = (unsigned short)(vreg[i].x >> 16);
                vd[2 * (RS / 2)] = (unsigned short)(vreg[i].y & 0xffffu); vd[3 * (RS / 2)] = (unsigned short)(vreg[i].y >> 16);
                vd[4 * (RS / 2)] = (unsigned short)(vreg[i].z & 0xffffu); vd[5 * (RS / 2)] = (unsigned short)(vreg[i].z >> 16);
                vd[6 * (RS / 2)] = (unsigned short)(vreg[i].w & 0xffffu); vd[7 * (RS / 2)] = (unsigned short)(vreg[i].w >> 16);
            }
        }
        __syncthreads();
        if (jp + 2 < nt) U64_LOAD(0, jp + 2);
        if (jp + 3 < nt) U64_LOAD(1, jp + 3);
        if (FX) {
#pragma unroll 1
        for (int i = 0; i < 2; ++i) {
            if (jp + i >= nt) break;
            const ATT_LAS unsigned char* Ks = stg + i * KV_B; const ATT_LAS unsigned char* Vs = Ks + TILE_B;
            f32x16 xa0, xa1, xb0, xb1;
            { f32x16 z;
#pragma unroll
              for (int q = 0; q < 16; ++q) z[q] = 0.f;
#pragma unroll
              for (int d = 0; d < 4; ++d) {
                  const bf16x8 ka = *(const ATT_LAS bf16x8*)(Ks + prow * RS + (16 * d + 8 * h) * 2), kb = *(const ATT_LAS bf16x8*)(Ks + (32 + prow) * RS + (16 * d + 8 * h) * 2);
                  if (d == 0) { xa0 = MFMA32(ka, qA[0], z); xa1 = MFMA32(kb, qA[0], z); xb0 = MFMA32(ka, qB[0], z); xb1 = MFMA32(kb, qB[0], z); }
                  else { xa0 = MFMA32(ka, qA[d], xa0); xa1 = MFMA32(kb, qA[d], xa1); xb0 = MFMA32(ka, qB[d], xb0); xb1 = MFMA32(kb, qB[d], xb1); }
              } }
            bf16x8 pA[4], pB[4];
            if (FX) __builtin_amdgcn_sched_barrier(0);
            softmax64<FX>(xa0, xa1, mA, lA, oA, first, pA);
            if (FX) __builtin_amdgcn_sched_barrier(0);
            softmax64<FX>(xb0, xb1, mB, lB, oB, first, pB);
            if (FX) __builtin_amdgcn_sched_barrier(0);
            first = false;
#pragma unroll
            for (int ks = 0; ks < 4; ++ks) {
                const bf16x8 va = *(const ATT_LAS bf16x8*)(Vs + r * RS + (16 * ks + 8 * h) * 2), vb = *(const ATT_LAS bf16x8*)(Vs + (32 + r) * RS + (16 * ks + 8 * h) * 2);
                oA[0] = MFMA32(va, pA[ks], oA[0]); oA[1] = MFMA32(vb, pA[ks], oA[1]); oB[0] = MFMA32(va, pB[ks], oB[0]); oB[1] = MFMA32(vb, pB[ks], oB[1]);
            }
        }
        } else {
#pragma unroll
        for (int i = 0; i < 2; ++i) {
            if (jp + i >= nt) break;
            const ATT_LAS unsigned char* Ks = stg + i * KV_B; const ATT_LAS unsigned char* Vs = Ks + TILE_B;
            f32x16 xa0, xa1, xb0, xb1;
            { f32x16 z;
#pragma unroll
              for (int q = 0; q < 16; ++q) z[q] = 0.f;
#pragma unroll
              for (int d = 0; d < 4; ++d) {
                  const bf16x8 ka = *(const ATT_LAS bf16x8*)(Ks + prow * RS + (16 * d + 8 * h) * 2), kb = *(const ATT_LAS bf16x8*)(Ks + (32 + prow) * RS + (16 * d + 8 * h) * 2);
                  if (d == 0) { xa0 = MFMA32(ka, qA[0], z); xa1 = MFMA32(kb, qA[0], z); xb0 = MFMA32(ka, qB[0], z); xb1 = MFMA32(kb, qB[0], z); }
                  else { xa0 = MFMA32(ka, qA[d], xa0); xa1 = MFMA32(kb, qA[d], xa1); xb0 = MFMA32(ka, qB[d], xb0); xb1 = MFMA32(kb, qB[d], xb1); }
              } }
            bf16x8 pA[4], pB[4];
            if (FX) __builtin_amdgcn_sched_barrier(0);
            softmax64<FX>(xa0, xa1, mA, lA, oA, first, pA);
            if (FX) __builtin_amdgcn_sched_barrier(0);
            softmax64<FX>(xb0, xb1, mB, lB, oB, first, pB);
            if (FX) __builtin_amdgcn_sched_barrier(0);
            first = false;
#pragma unroll
            for (int ks = 0; ks < 4; ++ks) {
                const bf16x8 va = *(const ATT_LAS bf16x8*)(Vs + r * RS + (16 * ks + 8 * h) * 2), vb = *(const ATT_LAS bf16x8*)(Vs + (32 + r) * RS + (16 * ks + 8 * h) * 2);
                oA[0] = MFMA32(va, pA[ks], oA[0]); oA[1] = MFMA32(vb, pA[ks], oA[1]); oB[0] = MFMA32(va, pB[ks], oB[0]); oB[1] = MFMA32(vb, pB[ks], oB[1]);
            }
        }
        }
    }
    lA = xsum32(lA); lB = xsum32(lB);
    const float iA = 1.f / lA, iB = 1.f / lB;
    const size_t orow = (size_t)b * SEQ + q_tok0 + wid * 64 + r;
    bf16_t* op = P.O + orow * 1024 + ocol + 4 * h;
#pragma unroll
    for (int dt = 0; dt < 2; ++dt)
#pragma unroll
        for (int g = 0; g < 4; ++g) {
            u32x2 w; w.x = pk(oA[dt][4 * g] * iA, oA[dt][4 * g + 1] * iA); w.y = pk(oA[dt][4 * g + 2] * iA, oA[dt][4 * g + 3] * iA);
            *(u32x2*)(op + 32 * dt + 8 * g) = w;
            u32x2 v; v.x = pk(oB[dt][4 * g] * iB, oB[dt][4 * g + 1] * iB); v.y = pk(oB[dt][4 * g + 2] * iB, oB[dt][4 * g + 3] * iB);
            *(u32x2*)(op + 32 * 1024 + 32 * dt + 8 * g) = v; }
    __syncthreads();
#undef U64_LOAD
}
}
#define GAS __attribute__((address_space(1)))
#define LAS __attribute__((address_space(3)))
typedef unsigned short bf16;
typedef unsigned v4u __attribute__((ext_vector_type(4)));
typedef float f32x4 __attribute__((ext_vector_type(4)));
typedef short bf16x8 __attribute__((ext_vector_type(8)));
typedef GAS unsigned gu32;
typedef GAS unsigned long long gu64;
#define RLX_AGENT __ATOMIC_RELAXED, __HIP_MEMORY_SCOPE_AGENT
#define LDS_WAIT() asm volatile("s_waitcnt lgkmcnt(0)" ::: "memory")
#define VM_WAIT() asm volatile("s_waitcnt vmcnt(0)" ::: "memory")
__device__ __forceinline__ unsigned long long rt() { return __builtin_amdgcn_s_memrealtime(); }
__device__ __forceinline__ unsigned f2bf(float f) { unsigned u = __builtin_bit_cast(unsigned, f); return (u + 0x7fffu + ((u >> 16) & 1u)) >> 16; }
__device__ __forceinline__ unsigned pk2(float lo, float hi) { return f2bf(lo) | (f2bf(hi) << 16); }

#define XB_TMO      128
#define XB_XCNT(j)  (256  + 64 * (j))
#define XB_XSUB(j)  (1280 + 64 * (j))
#define XB_XGEN(j)  (2304 + 64 * (j))
#define XB_TOP      3328
#define XB_TOPGEN   3392
#define XCD_BAR_WORDS 3456
#define XB_SPIN_CAP (1u << 18)

__device__ __forceinline__ unsigned xb_ld(unsigned* p)              { return __hip_atomic_load(p, __ATOMIC_RELAXED, __HIP_MEMORY_SCOPE_AGENT); }
__device__ __forceinline__ unsigned xb_add(unsigned* p, unsigned v) { return __hip_atomic_fetch_add(p, v, __ATOMIC_RELAXED, __HIP_MEMORY_SCOPE_AGENT); }
__device__ __forceinline__ unsigned xb_xcc_id() { return (unsigned)__builtin_amdgcn_s_getreg((3 << 11) | 20) & 0xFu; }
#define XB_SPIN(cond, bar) do { unsigned _sp = 0; while (cond) { __builtin_amdgcn_s_sleep(1); \
    if ((++_sp & 255u) == 0u) { if (xb_ld(&(bar)[XB_TMO])) break; if (_sp > XB_SPIN_CAP) { atomicAdd(&(bar)[XB_TMO], 1u); break; } } } } while (0)

struct XcdBarrier {
    unsigned* bar; unsigned x;
    volatile LAS unsigned* st;
};

__device__ __forceinline__ XcdBarrier xcd_barrier_post(unsigned* bar, volatile LAS unsigned* st) {
    XcdBarrier b; b.bar = bar; b.x = xb_xcc_id(); b.st = st;
    if (threadIdx.x == 0) (void)xb_add(&bar[XB_XCNT(b.x)], 1u);
    return b;
}
__device__ __forceinline__ void xcd_barrier_complete(unsigned* bar, unsigned x, unsigned& nloc, unsigned& nx) {
    const unsigned G = gridDim.x * gridDim.y * gridDim.z;
    unsigned sum, cnt, mine, sp = 0u;
    for (;;) {
        sum = 0u; cnt = 0u; mine = 0u;
#pragma unroll
        for (unsigned j = 0; j < 16; ++j) { const unsigned c = xb_ld(&bar[XB_XCNT(j)]); sum += c; cnt += (c > 0u) ? 1u : 0u; mine = (j == x) ? c : mine; }
        if (sum == G) break;
        __builtin_amdgcn_s_sleep(1);
        if ((++sp & 255u) == 0u) { if (xb_ld(&bar[XB_TMO])) break; if (sp > XB_SPIN_CAP) { atomicAdd(&bar[XB_TMO], 1u); break; } }
    }
    nloc = mine > 0u ? mine : 1u; nx = cnt > 0u ? cnt : 1u;
}

__device__ __forceinline__ void xcd_barrier(const XcdBarrier& b) {
    asm volatile("s_waitcnt vmcnt(0)" ::: "memory");
    __syncthreads();
    if (threadIdx.x == 0) {
        unsigned* bar = b.bar;
        __builtin_amdgcn_s_waitcnt(0);
        unsigned nloc = b.st[0], nx = b.st[1];
        if (nloc == 0u) { xcd_barrier_complete(bar, b.x, nloc, nx); b.st[0] = nloc; b.st[1] = nx; }
        const unsigned old = xb_add(&bar[XB_XSUB(b.x)], 1u);
        const unsigned gen = old / nloc;
        if (old + 1u == (gen + 1u) * nloc) {
            __builtin_amdgcn_fence(__ATOMIC_RELEASE, "agent");
            asm volatile("s_waitcnt vmcnt(0)" ::: "memory");
            const unsigned og = xb_add(&bar[XB_TOP], 1u);
            const unsigned tg = og / nx;
            if (og + 1u == (tg + 1u) * nx) xb_add(&bar[XB_TOPGEN], 1u);
            else XB_SPIN(xb_ld(&bar[XB_TOPGEN]) == tg, bar);
            __builtin_amdgcn_fence(__ATOMIC_ACQUIRE, "agent");
            xb_add(&bar[XB_XGEN(b.x)], 1u);
            asm volatile("s_waitcnt vmcnt(0)" ::: "memory");
        } else {
            XB_SPIN(xb_ld(&bar[XB_XGEN(b.x)]) == gen, bar);
            __builtin_amdgcn_fence(__ATOMIC_ACQUIRE, "agent");
            asm volatile("s_waitcnt vmcnt(0)" ::: "memory");
        }
    }
    __syncthreads();
}
constexpr int NWAVES = 8, NTHREADS = 512;
constexpr int BATCH = 8, SEQ = 4096, DM = 1024, CTXL = 256, ST = SEQ + CTXL, FFN = 2816, UGC = 2 * FFN, INC = 2304, NSLOT = 36;
constexpr int LAT_ROWS = BATCH * SEQ, CTX_ROWS = BATCH * CTXL, MROWS = LAT_ROWS + CTX_ROWS;
constexpr float EPS = 1e-6f;
constexpr size_t MiB = 1u << 20;
constexpr size_t WS_CTL = 0, CTL_ZERO_BYTES = 1 * MiB;
constexpr size_t WS_MOD = 1 * MiB;
constexpr size_t WS_TAB = 1 * MiB + 512 * 1024;
constexpr size_t WS_W = 2 * MiB, W_LAYER = 23 * MiB, W_IN = 0, W_OUT = 4 * MiB + 512 * 1024, W_UP = 6 * MiB + 512 * 1024, W_DN = 17 * MiB + 512 * 1024;
constexpr size_t WS_XC = 48 * MiB;
constexpr size_t WS_XN = 56 * MiB;
constexpr size_t WS_QKV = 124 * MiB;
constexpr size_t WS_UG = 124 * MiB;
constexpr size_t WS_ACT = 124 * MiB;
constexpr size_t WS_SB = 322 * MiB;
constexpr size_t WS_END = 370 * MiB;
constexpr size_t WS_DUMMY = 370 * MiB;
static_assert(WS_QKV + (size_t)BATCH * NSLOT * ST * 64 * 2 <= WS_SB && WS_ACT + (size_t)MROWS * FFN * 2 <= WS_SB && WS_SB + (size_t)(MROWS / 64) * 4 * UGC * 4 <= WS_END, "ws map");
static_assert(WS_XN + (size_t)MROWS * DM * 2 <= WS_QKV && WS_W + 2 * W_LAYER <= WS_XC, "ws map 2");
constexpr int CW_BAR = 4096;
constexpr int LDS_BYTES = 147456, MISC_OFF = 131072 + 320;
constexpr int P0_SCR = 8704, P0_SILU = 73728;
constexpr int TAB_LDS = 131072 + 1024;
static_assert(TAB_LDS + 12288 <= LDS_BYTES, "LDS map");
#ifndef AT_REPEAT
#define AT_REPEAT 1
#endif
#ifndef AT_ABL
#define AT_ABL 0
#endif
#ifndef REP_P0
#define REP_P0 1
#endif
#ifndef REP_N
#define REP_N 1
#endif
#ifndef REP_G1
#define REP_G1 1
#endif
#ifndef REP_G3
#define REP_G3 1
#endif
#ifndef PH_G1
#define PH_G1 1
#endif
#ifndef PH_AT
#define PH_AT 1
#endif
#ifndef PH_G2
#define PH_G2 1
#endif
#ifndef PH_G3
#define PH_G3 1
#endif
#ifndef PH_G4
#define PH_G4 1
#endif


__device__ __forceinline__ float wave_sum(float v) {
    int ln = (int)__lane_id(); asm volatile("" : "+v"(ln));
#pragma unroll
    for (int o = 1; o < 64; o <<= 1) v += __builtin_bit_cast(float, __builtin_amdgcn_ds_bpermute((ln ^ o) << 2, __builtin_bit_cast(int, v)));
    return v;
}
__device__ __forceinline__ void p0_transpose_item(const float* W, int K, int N, bf16* WT, LAS float* scr, int kb, int n0, int dn0, int lane) {
    const int k0 = 64 * kb;
#pragma unroll 16
    for (int i = 0; i < 32; ++i) { const int kk = 2 * i + (lane >> 5); scr[kk * 33 + (lane & 31)] = W[(size_t)(k0 + kk) * N + n0 + (lane & 31)]; }
    LDS_WAIT(); asm volatile("" ::: "memory");
    const int c = lane & 7;
#pragma unroll
    for (int j = 0; j < 4; ++j) { const int n = (lane >> 3) + 8 * j; const LAS float* s = scr + (8 * c) * 33 + n;
        v4u o; o.x = pk2(s[0 * 33], s[1 * 33]); o.y = pk2(s[2 * 33], s[3 * 33]); o.z = pk2(s[4 * 33], s[5 * 33]); o.w = pk2(s[6 * 33], s[7 * 33]);
        *(GAS v4u*)(WT + (size_t)(dn0 + n) * K + k0 + 8 * c) = o; }
    LDS_WAIT(); asm volatile("" ::: "memory");
}
struct Args { const float* in[26]; float* out; unsigned char* ws; };

__device__ __forceinline__ void norm_phase(const float* src_lat, const float* src_ctx, const float* g, const float* mod, int sh_off, int sc_off, bf16* XN, int r_begin, int r_end, int gw, int NGW, int lane) {
    f32x4 gv[4];
#pragma unroll
    for (int j = 0; j < 4; ++j) gv[j] = *(const f32x4*)(g + 4 * lane + 256 * j);
    for (int m = r_begin + gw; m < r_end; m += NGW) {
        const bool lat = m < LAT_ROWS;
        const float* xr = lat ? src_lat + (size_t)m * DM : src_ctx + (size_t)(m - LAT_ROWS) * DM;
        const float* mr = mod + (size_t)(lat ? (m >> 12) : 8) * 6144;
        f32x4 v[4]; float s = 0.f;
#pragma unroll
        for (int j = 0; j < 4; ++j) { v[j] = *(const f32x4*)(xr + 4 * lane + 256 * j); s += (v[j].x * v[j].x + v[j].y * v[j].y) + (v[j].z * v[j].z + v[j].w * v[j].w); }
        const float rstd = rsqrtf(wave_sum(s) * (1.f / DM) + EPS);
        unsigned long long* o8 = (unsigned long long*)(XN + (size_t)m * DM) + lane;
#pragma unroll
        for (int j = 0; j < 4; ++j) { const f32x4 sh = *(const f32x4*)(mr + sh_off + 4 * lane + 256 * j), sc = *(const f32x4*)(mr + sc_off + 4 * lane + 256 * j);
            const f32x4 y = ((v[j] * rstd) * gv[j]) * (sc + 1.0f) + sh;
            o8[64 * j] = (unsigned long long)pk2(y.x, y.y) | ((unsigned long long)pk2(y.z, y.w) << 32); }
    }
}
__device__ __forceinline__ float bf_lo(unsigned w) { return __uint_as_float(w << 16); }
__device__ __forceinline__ float bf_hi(unsigned w) { return __uint_as_float(w & 0xffff0000u); }
__device__ __forceinline__ float silu_f(float x) { return x / (1.f + __expf(-x)); }
__device__ __forceinline__ void conv_load8(const bf16* p, float (&o)[8]) { const v4u w = *(const v4u*)p; o[0] = bf_lo(w.x); o[1] = bf_hi(w.x); o[2] = bf_lo(w.y); o[3] = bf_hi(w.y); o[4] = bf_lo(w.z); o[5] = bf_hi(w.z); o[6] = bf_lo(w.w); o[7] = bf_hi(w.w); }
__device__ __forceinline__ void conv_phase(const bf16* UG, bf16* ACT, const float* cw, const float* cb, int row0, int nrows, int gtid, int NGT) {
    constexpr int RB = 16;
    const int total = (nrows / RB) * 352;
    for (int it = gtid; it < total; it += NGT) {
        const int rb = it / 352, c8 = (it - rb * 352) * 8, rr0 = rb * RB, r0 = row0 + rr0;
        const int per = r0 < LAT_ROWS ? SEQ : CTXL;
        const bool first = (r0 % per) == 0, last = ((r0 + RB) % per) == 0;
        float wu[3][8], wg[3][8], bu[8], bg[8];
#pragma unroll
        for (int t = 0; t < 3; ++t)
#pragma unroll
            for (int q = 0; q < 2; ++q) { const f32x4 a = *(const f32x4*)(cw + t * UGC + c8 + 4 * q), g = *(const f32x4*)(cw + t * UGC + FFN + c8 + 4 * q);
                wu[t][4 * q] = a.x; wu[t][4 * q + 1] = a.y; wu[t][4 * q + 2] = a.z; wu[t][4 * q + 3] = a.w; wg[t][4 * q] = g.x; wg[t][4 * q + 1] = g.y; wg[t][4 * q + 2] = g.z; wg[t][4 * q + 3] = g.w; }
#pragma unroll
        for (int q = 0; q < 2; ++q) { const f32x4 a = *(const f32x4*)(cb + c8 + 4 * q), g = *(const f32x4*)(cb + FFN + c8 + 4 * q);
            bu[4 * q] = a.x; bu[4 * q + 1] = a.y; bu[4 * q + 2] = a.z; bu[4 * q + 3] = a.w; bg[4 * q] = g.x; bg[4 * q + 1] = g.y; bg[4 * q + 2] = g.z; bg[4 * q + 3] = g.w; }
        const bf16* pu = UG + (size_t)rr0 * UGC + c8;
        float up[8], uc[8], un[8], gp[8], gc[8], gn[8];
        if (first) {
#pragma unroll
            for (int i = 0; i < 8; ++i) { up[i] = 0.f; gp[i] = 0.f; }
        } else { conv_load8(pu - UGC, up); conv_load8(pu - UGC + FFN, gp); }
        conv_load8(pu, uc); conv_load8(pu + FFN, gc);
#pragma unroll 4
        for (int k = 0; k < RB; ++k) {
            if (k == RB - 1 && last) {
#pragma unroll
                for (int i = 0; i < 8; ++i) { un[i] = 0.f; gn[i] = 0.f; }
            } else { conv_load8(pu + (size_t)(k + 1) * UGC, un); conv_load8(pu + (size_t)(k + 1) * UGC + FFN, gn); }
            float res[8];
#pragma unroll
            for (int i = 0; i < 8; ++i) {
                const float u = up[i] * wu[0][i] + uc[i] * wu[1][i] + un[i] * wu[2][i] + bu[i];
                const float g = gp[i] * wg[0][i] + gc[i] * wg[1][i] + gn[i] * wg[2][i] + bg[i];
                res[i] = silu_f(g) * u;
                up[i] = uc[i]; uc[i] = un[i]; gp[i] = gc[i]; gc[i] = gn[i];
            }
            v4u w; w.x = pk2(res[0], res[1]); w.y = pk2(res[2], res[3]); w.z = pk2(res[4], res[5]); w.w = pk2(res[6], res[7]);
            *(v4u*)(ACT + (size_t)(rr0 + k) * FFN + c8) = w;
        }
    }
}

__device__ __forceinline__ void fix_phase(const float* SB, bf16* ACT, const float* cw, const float* cb, int nseg, int gtid, int NGT) {
    const int total = nseg * 2 * 352;
    for (int it = gtid; it < total; it += NGT) {
        const int t = it / 352, c8 = (it - t * 352) * 8, side = t & 1, seg = t >> 1;
        const int row = seg * 64 + (side ? 63 : 0), per = row < LAT_ROWS ? SEQ : CTXL;
        const bool edge = side ? (((row + 1) % per) == 0) : ((row % per) == 0);
        const float* pc = SB + (size_t)(seg * 4 + (side ? 3 : 0)) * UGC + c8;
        const float* pp = side ? pc - UGC : pc - UGC;
        const float* pn = pc + UGC;
        float res[8];
#pragma unroll
        for (int half = 0; half < 2; ++half) {
            const int col = half * FFN + c8;
            float o[8];
#pragma unroll
            for (int q = 0; q < 2; ++q) {
                const f32x4 z = {0.f, 0.f, 0.f, 0.f};
                const f32x4 a = (!side && edge) ? z : *(const f32x4*)(pp + half * FFN + 4 * q), b = *(const f32x4*)(pc + half * FFN + 4 * q), c = (side && edge) ? z : *(const f32x4*)(pn + half * FFN + 4 * q);
                const f32x4 w0 = *(const f32x4*)(cw + col + 4 * q), w1 = *(const f32x4*)(cw + UGC + col + 4 * q), w2 = *(const f32x4*)(cw + 2 * UGC + col + 4 * q), bb = *(const f32x4*)(cb + col + 4 * q);
                const f32x4 v = a * w0 + b * w1 + c * w2 + bb;
                o[4 * q] = v.x; o[4 * q + 1] = v.y; o[4 * q + 2] = v.z; o[4 * q + 3] = v.w;
            }
            if (half == 0) {
#pragma unroll
                for (int i = 0; i < 8; ++i) res[i] = o[i];
            } else {
#pragma unroll
                for (int i = 0; i < 8; ++i) res[i] = silu_f(o[i]) * res[i];
            }
        }
        v4u w; w.x = pk2(res[0], res[1]); w.y = pk2(res[2], res[3]); w.z = pk2(res[4], res[5]); w.w = pk2(res[6], res[7]);
        *(v4u*)(ACT + (size_t)row * FFN + c8) = w;
    }
}

typedef const __attribute__((address_space(4))) Args* ArgsP;
#define GET_ARGS() ({ ArgsP _p = (ArgsP)__builtin_amdgcn_kernarg_segment_ptr(); asm volatile("" : "+s"(_p)); _p; })
__global__ void __launch_bounds__(NTHREADS, 2) fwd_megakernel(Args args_unused) {
    extern __shared__ __attribute__((aligned(16))) unsigned char lds_raw[];
    LAS unsigned char* lds = (LAS unsigned char*)lds_raw;
    const int G = gridDim.x, bx = blockIdx.x;
    const int vcu = (G % 8 == 0) ? (bx % 8) * (G / 8) + bx / 8 : bx;
    const int NGW = G * NWAVES;
#define PHASE_IDS() int tid = threadIdx.x; asm volatile("" : "+v"(tid)); const int lane = tid & 63, wave = __builtin_amdgcn_readfirstlane(tid >> 6), gw = vcu * NWAVES + wave; (void)lane; (void)gw
    for (int u = threadIdx.x; u < (LDS_BYTES - 131072) / 4; u += NTHREADS) ((LAS unsigned*)(lds + 131072))[u] = 0u;
    __syncthreads();
    XcdBarrier bar;
    { ArgsP A = GET_ARGS(); bar = xcd_barrier_post((unsigned*)(A->ws + WS_CTL) + CW_BAR, (volatile LAS unsigned*)(lds + MISC_OFF) + 8); }
#ifndef BAR_REP
#define BAR_REP 1
#endif
#define GRID_BAR() do { for (int br_ = 0; br_ < BAR_REP; ++br_) xcd_barrier(bar); } while (0)

    for (int rep_ = 0; rep_ < REP_P0; ++rep_) {
        PHASE_IDS();
        ArgsP A = GET_ARGS();
        unsigned char* ws = A->ws;
        LAS float* silu = (LAS float*)(lds + P0_SILU);
        { const float* c_in = A->in[1]; const float* cctx_in = A->in[3];
          for (int i = tid; i < 9 * 1024; i += NTHREADS) { const float v = (i < 8192) ? c_in[i] : cctx_in[i - 8192]; silu[i] = silu_f(v); } }
        __syncthreads();
        if (gw < 768) {
            const int l = gw / 384, col = (gw % 384) * 16 + (lane & 15), kq = lane >> 4;
            const float* wp = A->in[4] + (size_t)l * DM * 6144 + col;
            float* mod = (float*)(ws + WS_MOD);
            float a[9];
#pragma unroll
            for (int r = 0; r < 9; ++r) a[r] = 0.f;
#pragma unroll 16
            for (int k = kq; k < DM; k += 4) { const float w = wp[(size_t)k * 6144];
#pragma unroll
                for (int r = 0; r < 9; ++r) a[r] += silu[r * 1024 + k] * w; }
#pragma unroll
            for (int r = 0; r < 9; ++r) { a[r] += __shfl_xor(a[r], 16); a[r] += __shfl_xor(a[r], 32); }
            if (kq == 0) { const float bb = A->in[5][l * 6144 + col];
#pragma unroll
                for (int r = 0; r < 9; ++r) mod[(size_t)(l * 9 + r) * 6144 + col] = a[r] + bb; }
        }
        if (bx == 0) {
            float* tabA = (float*)(ws + WS_TAB); float* tabC = (float*)(ws + WS_TAB + 8192);
            for (int i = tid; i < 64 * 24; i += NTHREADS) {
                const int pos = i / 24, f = i % 24;
                const float inv = (f < 16) ? exp2f(-(float)(2 * f) * (1.f / 32.f) * 13.287712379549449f) : exp2f(-(float)(2 * (f - 16)) * (1.f / 16.f) * 13.287712379549449f);
                const float ang = (float)pos * inv;
                const double rev = (double)ang * 0.15915494309189535; const float fr = (float)(rev - floor(rev));
                const float cv = __builtin_amdgcn_cosf(fr), sv = __builtin_amdgcn_sinf(fr);
                if (f < 16) { tabA[(pos * 16 + f) * 2] = cv; tabA[(pos * 16 + f) * 2 + 1] = sv; } else { tabC[(pos * 8 + f - 16) * 2] = cv; tabC[(pos * 8 + f - 16) * 2 + 1] = sv; }
            }
        }
        LAS float* scr = (LAS float*)(lds + wave * P0_SCR);
        constexpr int I_IN = 16 * 72, I_OUT = 16 * 32, I_UP = 16 * 176, I_DN = 44 * 32, I_L = I_IN + I_OUT + I_UP + I_DN;
        for (int it = gw; it < 2 * I_L; it += NGW) {
            const int l = it / I_L; int r = it % I_L;
            bf16* wb = (bf16*)(ws + WS_W + (size_t)l * W_LAYER);
            if (r < I_IN) { const int kb = r / 72, nb = r % 72, n0 = nb * 32;
                const int pn = n0 >> 8, wc = (n0 >> 6) & 3, bj = (n0 >> 5) & 1;
                p0_transpose_item(A->in[7] + (size_t)l * DM * INC, DM, INC, (bf16*)((unsigned char*)wb + W_IN), scr, kb, n0, pn * 256 + bj * 128 + wc * 32, lane); continue; }
            r -= I_IN;
            if (r < I_OUT) { const int kb = r / 32, nb = r % 32; p0_transpose_item(A->in[20] + (size_t)l * DM * DM, DM, DM, (bf16*)((unsigned char*)wb + W_OUT), scr, kb, nb * 32, nb * 32, lane); continue; }
            r -= I_OUT;
            if (r < I_UP) { const int kb = r / 176, nb = r % 176, n0 = nb * 32, which = n0 / FFN, jj = n0 - which * FFN;
                p0_transpose_item(A->in[22] + (size_t)l * DM * UGC, DM, UGC, (bf16*)((unsigned char*)wb + W_UP), scr, kb, n0, (jj >> 7) * 256 + which * 128 + (jj & 127), lane); continue; }
            r -= I_UP;
            { const int kb = r / 32, nb = r % 32; p0_transpose_item(A->in[25] + (size_t)l * FFN * DM, FFN, DM, (bf16*)((unsigned char*)wb + W_DN), scr, kb, nb * 32, nb * 32, lane); }
        }
    }
    asm volatile("s_waitcnt vmcnt(0)" ::: "memory");
    cg::this_grid().sync();


    for (int l = 0; l < 2; ++l) {
        const bool with_ctx = (l == 0);
        const int mrows = with_ctx ? MROWS : LAT_ROWS;
        if (l == 0) {
            for (int rep_ = 0; rep_ < REP_N; ++rep_) { PHASE_IDS(); ArgsP A = GET_ARGS(); unsigned char* ws = A->ws;
              norm_phase(A->in[0], A->in[2], A->in[6], (const float*)(ws + WS_MOD), 0, 1024, (bf16*)(ws + WS_XN), 0, MROWS, gw, NGW, lane); }
            GRID_BAR();
        }
        for (int rep_ = 0; rep_ < REP_G1; ++rep_) if (PH_G1) {
            ArgsP A = GET_ARGS(); unsigned char* ws = A->ws;
            pg8::Gemm g{(const bf16*)(ws + WS_XN), (const bf16*)(ws + WS_W + (size_t)l * W_LAYER + W_IN), MROWS, INC, DM}; pg8::StaticOrder S; S.init(MROWS, INC, G, bx);
            { PHASE_IDS(); const float* tsrc = (const float*)(ws + WS_TAB);
              for (int i = tid; i < 3072; i += NTHREADS) ((LAS float*)(lds + TAB_LDS))[i] = tsrc[i];
              __syncthreads(); }
            pg8::EpiQKV E{(pg8::QkvArgsP)A, l, (unsigned)WS_QKV, (const LAS float*)(lds + TAB_LDS)};
            pg8::gemm_phase<pg8::EpiQKV, pg8::StaticOrder, true, true>(lds, g, S, E);
        }
        GRID_BAR();
        for (int rep_ = 0; rep_ < AT_REPEAT; ++rep_) if (PH_AT) {
            ArgsP A = GET_ARGS(); unsigned char* ws = A->ws;
            bool fxA, fxC;
            { const int li = (int)(threadIdx.x & 63u);
              float mqa = fabsf(A->in[8][l * 64 + li]), mka = fabsf(A->in[9][l * 64 + li]), mqc = fabsf(A->in[13][l * 32 + (li & 31)]), mkc = fabsf(A->in[14][l * 32 + (li & 31)]);
              int ln = (int)__lane_id(); asm volatile("" : "+v"(ln));
#pragma unroll
              for (int o = 1; o < 64; o <<= 1) {
                  mqa = fmaxf(mqa, __builtin_bit_cast(float, __builtin_amdgcn_ds_bpermute((ln ^ o) << 2, __builtin_bit_cast(int, mqa))));
                  mka = fmaxf(mka, __builtin_bit_cast(float, __builtin_amdgcn_ds_bpermute((ln ^ o) << 2, __builtin_bit_cast(int, mka))));
                  mqc = fmaxf(mqc, __builtin_bit_cast(float, __builtin_amdgcn_ds_bpermute((ln ^ o) << 2, __builtin_bit_cast(int, mqc))));
                  mkc = fmaxf(mkc, __builtin_bit_cast(float, __builtin_amdgcn_ds_bpermute((ln ^ o) << 2, __builtin_bit_cast(int, mkc)))); }
              fxA = __builtin_amdgcn_readfirstlane((int)(11.7f * mqa * mka < 30.f)) != 0; fxC = __builtin_amdgcn_readfirstlane((int)(8.3f * mqc * mkc < 30.f)) != 0; }
            const float lam_init = (l == 0) ? 0.2f : 0.35550906759096946f;
            float d1, d2;
            { const int li = (int)(threadIdx.x & 31u);
              d1 = wave_sum(A->in[15][l * 32 + li] * A->in[16][l * 32 + li]) * 0.5f; d2 = wave_sum(A->in[17][l * 32 + li] * A->in[18][l * 32 + li]) * 0.5f; }
            d1 = __builtin_bit_cast(float, __builtin_amdgcn_readfirstlane(__builtin_bit_cast(int, d1))); d2 = __builtin_bit_cast(float, __builtin_amdgcn_readfirstlane(__builtin_bit_cast(int, d2)));
            const bool abl_pass = (AT_ABL != 0) && (rep_ == 0);
            att::Params P{(const bf16*)(ws + WS_QKV), abl_pass ? (bf16*)(ws + WS_DUMMY) : (bf16*)(ws + WS_XN), A->in[12] + (size_t)l * 4 * 465, A->in[19] + l * 64, expf(d1) - expf(d2) + lam_init, 1.f - lam_init};
            if (AT_ABL != 0 && abl_pass) {
                for (int u = vcu; u < 1024; u += G) { const int b = u >> 7, hq = (u >> 4) & 7, qb = u & 15;
                    att::unit<0, AT_ABL>(P, lds, b, hq, 8 + (hq >> 2), 10 + (hq >> 2), qb * 256, 0, 68, hq * 64, 0); }
                for (int u = vcu; u < 512; u += G) { const int b = u >> 6, hc = (u >> 4) & 3, qb = u & 15;
                    att::unit<1, AT_ABL>(P, lds, b, 24 + hc, 28 + hc, 32 + hc, qb * 256, 0, 68, 768 + hc * 64, 0); }
                continue;
            }
            if (fxA) { for (int u = vcu; u < 1024; u += G) { const int b = u >> 7, hq = (u >> 4) & 7, qb = u & 15;
                att::unit<0, 0, true>(P, lds, b, hq, 8 + (hq >> 2), 10 + (hq >> 2), qb * 256, 0, 68, hq * 64, 0); } }
            else { for (int u = vcu; u < 512; u += G) { const int b = u >> 6, hq = (u >> 3) & 7, qb = u & 7;
                att::unit64<false>(P, lds, b, hq, 8 + (hq >> 2), 10 + (hq >> 2), qb * 512, 68, hq * 64); } }
            if (fxC) { for (int u = vcu; u < 512; u += G) { const int b = u >> 6, hc = (u >> 4) & 3, qb = u & 15;
                att::unit<1, 0, true>(P, lds, b, 24 + hc, 28 + hc, 32 + hc, qb * 256, 0, 68, 768 + hc * 64, 0); } }
            else { for (int u = vcu; u < 512; u += G) { const int b = u >> 6, hc = (u >> 4) & 3, qb = u & 15;
                att::unit<1>(P, lds, b, 24 + hc, 28 + hc, 32 + hc, qb * 256, 0, 68, 768 + hc * 64, 0); } }
            for (int u = vcu; u < 512; u += G) { const int b = u >> 6, hb = (u >> 4) & 3, qb = u & 15;
                att::unit<2>(P, lds, b, 12 + hb, 16 + hb, 20 + hb, qb * 256, 0, 0, 512 + hb * 64, hb); }
            if (with_ctx) for (int u = vcu; u < 128; u += G) { const int b = u >> 4, hh = u & 15;
                if (hh < 12) { const int qs = hh < 8 ? hh : 12 + (hh - 8), ks = hh < 8 ? 8 + (hh >> 2) : 16 + (hh - 8), vs = hh < 8 ? 10 + (hh >> 2) : 20 + (hh - 8), oc = hh < 8 ? hh * 64 : 512 + (hh - 8) * 64;
                    att::unit<0>(P, lds, b, qs, ks, vs, SEQ, 64, 4, oc, 0); }
                else att::unit<1>(P, lds, b, 24 + (hh - 12), 28 + (hh - 12), 32 + (hh - 12), SEQ, 64, 4, 768 + (hh - 12) * 64, 0); }
        }
        GRID_BAR();
        for (int part = 0; part < (with_ctx ? 2 : 1); ++part) {
            if (part == 0 || bx < 32) {
                if (PH_G2) {
                    ArgsP A = GET_ARGS(); unsigned char* ws = A->ws;
                    const int rows = part ? CTX_ROWS : LAT_ROWS, roff = part ? LAT_ROWS : 0;
                    pg8::Gemm g{(const bf16*)(ws + WS_XN) + (size_t)roff * DM, (const bf16*)(ws + WS_W + (size_t)l * W_LAYER + W_OUT), rows, DM, DM}; pg8::StaticOrder S; S.init(rows, DM, G, bx);
                    pg8::EpiGateRes E{(l == 0) ? A->in[0] : A->out, (l == 0) ? A->in[2] : (const float*)(ws + WS_XC), A->out, (float*)(ws + WS_XC), (const float*)(ws + WS_MOD) + (size_t)l * 9 * 6144 + 2048, 6144, roff};
                    pg8::gemm_phase<pg8::EpiGateRes, pg8::StaticOrder, true, true>(lds, g, S, E);
                }
            } else { PHASE_IDS(); ArgsP A = GET_ARGS(); unsigned char* ws = A->ws;
                norm_phase(A->out, (const float*)(ws + WS_XC), A->in[21] + l * DM, (const float*)(ws + WS_MOD) + (size_t)l * 9 * 6144, 3072, 4096, (bf16*)(ws + WS_XN), 0, LAT_ROWS, (bx - 32) * NWAVES + wave, (G - 32) * NWAVES, lane); }
            GRID_BAR();
        }
        for (int rep_ = 0; rep_ < REP_N; ++rep_) { PHASE_IDS(); ArgsP A = GET_ARGS(); unsigned char* ws = A->ws;
          norm_phase(A->out, (const float*)(ws + WS_XC), A->in[21] + l * DM, (const float*)(ws + WS_MOD) + (size_t)l * 9 * 6144, 3072, 4096, (bf16*)(ws + WS_XN), with_ctx ? LAT_ROWS : 0, with_ctx ? MROWS : LAT_ROWS, gw, NGW, lane); }
        GRID_BAR();
        for (int rep_ = 0; rep_ < REP_G3; ++rep_) if (PH_G3) {
            ArgsP A = GET_ARGS(); unsigned char* ws = A->ws;
            pg8::Gemm g{(const bf16*)(ws + WS_XN), (const bf16*)(ws + WS_W + (size_t)l * W_LAYER + W_UP), mrows, UGC, DM}; pg8::StaticOrder S; S.init(mrows, UGC, G, bx);
            pg8::EpiConv E{(bf16*)(ws + WS_ACT), (float*)(ws + WS_SB), A->in[23] + (size_t)l * 3 * UGC, A->in[24] + (size_t)l * UGC};
            pg8::gemm_phase<pg8::EpiConv, pg8::StaticOrder, true, true>(lds, g, S, E);
        }
        GRID_BAR();
        { PHASE_IDS(); ArgsP A = GET_ARGS(); unsigned char* ws = A->ws;
          fix_phase((const float*)(ws + WS_SB), (bf16*)(ws + WS_ACT), A->in[23] + (size_t)l * 3 * UGC, A->in[24] + (size_t)l * UGC, mrows / 64, vcu * NTHREADS + tid, G * NTHREADS); }
        GRID_BAR();
        for (int part = 0; part < (with_ctx ? 2 : 1); ++part) {
            if (part == 0 || bx < 32) {
                if (PH_G4) {
                    ArgsP A = GET_ARGS(); unsigned char* ws = A->ws;
                    const int rows = part ? CTX_ROWS : LAT_ROWS, roff = part ? LAT_ROWS : 0;
                    pg8::Gemm g{(const bf16*)(ws + WS_ACT) + (size_t)roff * FFN, (const bf16*)(ws + WS_W + (size_t)l * W_LAYER + W_DN), rows, DM, FFN}; pg8::StaticOrder S; S.init(rows, DM, G, bx);
                    pg8::EpiGateRes E{A->out, (const float*)(ws + WS_XC), A->out, (float*)(ws + WS_XC), (const float*)(ws + WS_MOD) + (size_t)l * 9 * 6144 + 5120, 6144, roff};
                    pg8::gemm_phase<pg8::EpiGateRes, pg8::StaticOrder, true, true>(lds, g, S, E);
                }
            } else { PHASE_IDS(); ArgsP A = GET_ARGS(); unsigned char* ws = A->ws;
                norm_phase(A->out, (const float*)(ws + WS_XC), A->in[6] + DM, (const float*)(ws + WS_MOD) + (size_t)9 * 6144, 0, 1024, (bf16*)(ws + WS_XN), 0, LAT_ROWS, (bx - 32) * NWAVES + wave, (G - 32) * NWAVES, lane); }
            if (l == 0) GRID_BAR();
        }
        if (l == 0) {
            { PHASE_IDS(); ArgsP A = GET_ARGS(); unsigned char* ws = A->ws;
              norm_phase(A->out, (const float*)(ws + WS_XC), A->in[6] + DM, (const float*)(ws + WS_MOD) + (size_t)9 * 6144, 0, 1024, (bf16*)(ws + WS_XN), LAT_ROWS, MROWS, gw, NGW, lane); }
            GRID_BAR();
        }
    }
}

extern "C" void kernel_launch(void* const* d_in, const int* in_sizes, int n_in, void* d_out, int out_size, void* d_ws, size_t ws_size, hipStream_t stream) {
    static int grid = 0;
    if (grid == 0) {
        int dev = 0, cus = 0, per_cu = 0;
        if (n_in != 26 || ws_size < WS_END) { fprintf(stderr, "kernel_launch: unexpected n_in %d / ws %zu\n", n_in, ws_size); grid = -1; return; }
        if (hipGetDevice(&dev) != hipSuccess || hipDeviceGetAttribute(&cus, hipDeviceAttributeMultiprocessorCount, dev) != hipSuccess) { grid = -1; return; }
        if (hipFuncSetAttribute((const void*)fwd_megakernel, hipFuncAttributeMaxDynamicSharedMemorySize, LDS_BYTES) != hipSuccess) { fprintf(stderr, "kernel_launch: hipFuncSetAttribute failed\n"); grid = -1; return; }
        if (hipOccupancyMaxActiveBlocksPerMultiprocessor(&per_cu, (const void*)fwd_megakernel, NTHREADS, LDS_BYTES) != hipSuccess || per_cu < 1) per_cu = 1;
        (void)hipGetLastError();
        grid = cus;
    }
    if (grid < 0) return;
    (void)hipMemsetAsync((char*)d_ws + WS_CTL, 0, CTL_ZERO_BYTES, stream);
    Args a{};
    for (int i = 0; i < 26; ++i) a.in[i] = (const float*)d_in[i];
    a.out = (float*)d_out; a.ws = (unsigned char*)d_ws;
    void* kargs[] = {&a};
    hipError_t e = hipLaunchCooperativeKernel((const void*)fwd_megakernel, dim3(grid), dim3(NTHREADS), kargs, LDS_BYTES, stream);
    if (e != hipSuccess) fprintf(stderr, "cooperative launch failed: %s (grid %d)\n", hipGetErrorString(e), grid);
}
```

```cpp
#include <hip/hip_runtime.h>
#include <hip/hip_cooperative_groups.h>
#include <cstdio>
#include <cstdint>
namespace cg = cooperative_groups;
namespace pg8 {
#define PG8_LAS __attribute__((address_space(3)))
typedef unsigned short bf16_t;
typedef short bf16x8 __attribute__((ext_vector_type(8)));
typedef float f32x4 __attribute__((ext_vector_type(4)));
typedef unsigned u32x4 __attribute__((ext_vector_type(4)));
constexpr int BM = 256, BK = 64, HALF = 128, HTB = HALF * BK * 2  , STAGE_BYTES = 8 * HTB, NXCD = 8, WGM = 8;

__host__ __device__ __forceinline__ int lds_byte(int r, int c) { const int st = (r >> 4) * 2 + (c >> 5), rr = r & 15, cc = c & 31, ob = rr * 64 + cc * 2; return st * 1024 + (ob ^ (((ob >> 9) & 1) << 5)); }
__host__ __device__ __forceinline__ void stage_rc(int b, int& R, int& C) { const int st = b / 1024, sb = b % 1024, swz = sb ^ (((sb >> 9) & 1) << 5); R = (st >> 1) * 16 + swz / 64; C = (st & 1) * 32 + (swz % 64) / 2; }
__host__ __device__ __forceinline__ int perm32(int rho) { const int n = rho >> 4, i = rho & 15; return 8 * (i >> 2) + 4 * n + (i & 3); }

struct Unit { int pm, pn; };
struct Gemm { const bf16_t* A; const bf16_t* Bt; int M, N, K; };

struct StaticOrder {
    int nM, nN, nwg, G, c;
    __host__ __device__ void init(int M, int N, int G_, int c_) { nM = M / BM; nN = N / BM; nwg = nM * nN; G = G_; c = c_; }
    __host__ __device__ bool next(int i, Unit& u) const {
        const long L = (long)i * G + c; if (L >= nwg) return false;
        int wgid = (int)L; { const int q = nwg / NXCD, r = nwg % NXCD, xcd = wgid % NXCD, off = wgid / NXCD; wgid = (xcd < r ? xcd * (q + 1) : r * (q + 1) + (xcd - r) * q) + off; }
        const int nig = WGM * nN, gid = wgid / nig, fm = gid * WGM, gsz = (nM - fm) < WGM ? (nM - fm) : WGM;
        u.pm = fm + ((wgid % nig) % gsz); u.pn = (wgid % nig) / gsz; return true;
    }
    __device__ __forceinline__ void a_ready(const Unit&) const {}
    __device__ __forceinline__ void done(const Unit&) const {}
};

__device__ __forceinline__ unsigned cvt_pk_bf16(float lo, float hi) { unsigned r; asm volatile("v_cvt_pk_bf16_f32 %0, %1, %2" : "=v"(r) : "v"(lo), "v"(hi)); return r; }
typedef float f32x2 __attribute__((ext_vector_type(2)));
__device__ __forceinline__ f32x2 gelu_pk(f32x2 v) {
    const f32x2 av = __builtin_elementwise_abs(v), d = av * 0.2316418882f + 1.0f;
    f32x2 t; t.x = __builtin_amdgcn_rcpf(d.x); t.y = __builtin_amdgcn_rcpf(d.y);
    f32x2 q = t * 0.5307027145f + (-0.7265760135f); q = q * t + 0.7107068705f; q = q * t + (-0.142248368f); q = q * t + 0.127414796f; q = q * t;
    const f32x2 s = (v * v) * (-0.72134752044f);
    f32x2 e; e.x = __builtin_amdgcn_exp2f(s.x); e.y = __builtin_amdgcn_exp2f(s.y);
    const f32x2 m = v * (q * e), r = v - m;
    f32x2 o; o.x = v.x < 0.f ? m.x : r.x; o.y = v.y < 0.f ? m.y : r.y; return o;
}

template <int ACT  > struct EpiBf16 {
    static constexpr bool PERM = true, AFTER_DRAIN = false, AMAP = false; static_assert(ACT == 0 || ACT == 1, "EpiBf16: ACT is 0 (none) or 1 (gelu_pk)");
    bf16_t* O; int ldc; const float* bias; int split_cols; size_t split_stride; float scale0;
    __device__ __forceinline__ void operator()(const f32x4 (&acc)[2][2][4][2], const Unit& u, int wr, int wc, int fr, int fq) const {
        const int row0 = u.pm * BM + wr * 64 + fr; int colt = u.pn * BM; bf16_t* base = O;
        float sc = 1.f; if (split_cols) { const int t = colt / split_cols; base += (size_t)t * split_stride; colt -= t * split_cols; if (t == 0) sc = scale0; }
        const int col0 = colt + wc * 32 + 8 * fq, bcol0 = u.pn * BM + wc * 32 + 8 * fq;
        f32x4 bv[2][2];
#pragma unroll
        for (int bj = 0; bj < 2; ++bj)
#pragma unroll
            for (int n = 0; n < 2; ++n) bv[bj][n] = bias ? *(const f32x4*)(bias + bcol0 + bj * HALF + 4 * n) : (f32x4){0.f, 0.f, 0.f, 0.f};
#pragma unroll
        for (int ai = 0; ai < 2; ++ai)
#pragma unroll
            for (int m = 0; m < 4; ++m) { bf16_t* rowp = base + (size_t)(row0 + ai * HALF + m * 16) * ldc + col0;
#pragma unroll
                for (int bj = 0; bj < 2; ++bj) { f32x4 v0 = acc[ai][bj][m][0] + bv[bj][0], v1 = acc[ai][bj][m][1] + bv[bj][1];
                    if (ACT == 1) { f32x2 a = gelu_pk((f32x2){v0[0], v0[1]}), b = gelu_pk((f32x2){v0[2], v0[3]}), c = gelu_pk((f32x2){v1[0], v1[1]}), d = gelu_pk((f32x2){v1[2], v1[3]});
                        v0 = (f32x4){a.x, a.y, b.x, b.y}; v1 = (f32x4){c.x, c.y, d.x, d.y}; }
                    v0 = v0 * sc; v1 = v1 * sc; u32x4 w; w.x = cvt_pk_bf16(v0[0], v0[1]); w.y = cvt_pk_bf16(v0[2], v0[3]); w.z = cvt_pk_bf16(v1[0], v1[1]); w.w = cvt_pk_bf16(v1[2], v1[3]);
                    *(u32x4*)(rowp + bj * HALF) = w; } }
    }
};
constexpr int P_S = 4096, P_CTX = 256, P_ST = 4352, P_NSLOT = 36, P_LAT_ROWS = 32768;
constexpr float P_EPS = 1e-6f, P_LOG2E = 1.4426950408889634f;
typedef float f32x2e __attribute__((ext_vector_type(2)));
struct QkvArgs { const float* in[26]; float* out; unsigned char* ws; };
typedef const __attribute__((address_space(4))) QkvArgs* QkvArgsP;
struct EpiQKV {
    static constexpr bool PERM = true, AFTER_DRAIN = false, AMAP = false;
    QkvArgsP A; int l; unsigned qkv_off; const PG8_LAS float* tabL;
    __device__ __forceinline__ void operator()(const f32x4 (&acc)[2][2][4][2], const Unit& u, int wr, int wc, int fr, int fq) const {
        asm volatile("" : "+v"(fr), "+v"(fq));
        const int slot = u.pn * 4 + wc;
        int b, tok0; const bool lat = u.pm < 128;
        if (lat) { b = u.pm >> 4; tok0 = (u.pm & 15) * 256; } else { b = u.pm - 128; tok0 = P_S; }
        unsigned char* ws = A->ws;
        bf16_t* QKV = (bf16_t*)(ws + qkv_off); const PG8_LAS float* tabA = tabL; const PG8_LAS float* tabC = tabL + 2048;
        const float* g = nullptr; int rope = 0; bool half = false; float qs = 1.f;
        if (slot < 8) { g = A->in[8] + l * 64; rope = 1; qs = 0.125f * P_LOG2E; }
        else if (slot < 10) { g = A->in[9] + l * 64; rope = 1; }
        else if (slot < 12) { }
        else if (slot < 16) { g = A->in[10] + l * 64; qs = 0.125f * P_LOG2E; }
        else if (slot < 20) { g = A->in[11] + l * 64; }
        else if (slot < 24) { }
        else if (slot < 28) { g = A->in[13] + l * 32; rope = 2; half = true; qs = 0.17677669529663687f * P_LOG2E; }
        else if (slot < 32) { g = A->in[14] + l * 32; rope = 2; half = true; }
        if (!lat) rope = 0;
        f32x4 gv[2][2];
#pragma unroll
        for (int bj = 0; bj < 2; ++bj)
#pragma unroll
            for (int n = 0; n < 2; ++n) gv[bj][n] = g ? *(const f32x4*)(g + (half ? 0 : 32 * bj) + 8 * fq + 4 * n) : (f32x4){1.f, 1.f, 1.f, 1.f};
        bf16_t* base = QKV + ((size_t)(b * P_NSLOT + slot) * P_ST + tok0) * 64 + 8 * fq;
#pragma unroll
        for (int ai = 0; ai < 2; ++ai)
#pragma unroll
            for (int m = 0; m < 4; ++m) {
                const int R = ai * HALF + wr * 64 + m * 16 + fr;
                f32x4 v[2][2];
#pragma unroll
                for (int bj = 0; bj < 2; ++bj)
#pragma unroll
                    for (int n = 0; n < 2; ++n) v[bj][n] = acc[ai][bj][m][n];
                if (g) {
                    float ss[2];
#pragma unroll
                    for (int bj = 0; bj < 2; ++bj) { float s = 0.f;
#pragma unroll
                        for (int n = 0; n < 2; ++n) s += (v[bj][n][0] * v[bj][n][0] + v[bj][n][1] * v[bj][n][1]) + (v[bj][n][2] * v[bj][n][2] + v[bj][n][3] * v[bj][n][3]);
                        { const auto q = __builtin_amdgcn_permlane16_swap(__float_as_uint(s), __float_as_uint(s), false, false); s = __uint_as_float(q[0]) + __uint_as_float(q[1]); }
                        { const auto q = __builtin_amdgcn_permlane32_swap(__float_as_uint(s), __float_as_uint(s), false, false); s = __uint_as_float(q[0]) + __uint_as_float(q[1]); }
                        ss[bj] = s; }
                    float rs[2];
                    if (half) { rs[0] = rsqrtf(ss[0] * (1.f / 32.f) + P_EPS); rs[1] = rsqrtf(ss[1] * (1.f / 32.f) + P_EPS); }
                    else { rs[0] = rsqrtf((ss[0] + ss[1]) * (1.f / 64.f) + P_EPS); rs[1] = rs[0]; }
#pragma unroll
                    for (int bj = 0; bj < 2; ++bj)
#pragma unroll
                        for (int n = 0; n < 2; ++n) v[bj][n] = (v[bj][n] * rs[bj]) * gv[bj][n];
                    if (rope) {
                        const int tok = tok0 + R, rowpos = tok >> 6, colpos = tok & 63;
#pragma unroll
                        for (int bj = 0; bj < 2; ++bj) {
                            const PG8_LAS float* tp;
                            if (rope == 1) tp = tabA + ((bj == 0 ? rowpos : colpos) * 16 + 4 * fq) * 2;
                            else tp = tabC + ((fq < 2 ? rowpos : colpos) * 8 + 4 * (fq & 1)) * 2;
                            const f32x4 t0 = *(const PG8_LAS f32x4*)tp, t1 = *(const PG8_LAS f32x4*)(tp + 4);
                            { const f32x4 y = v[bj][0]; v[bj][0] = (f32x4){y[0] * t0[0] - y[1] * t0[1], y[0] * t0[1] + y[1] * t0[0], y[2] * t0[2] - y[3] * t0[3], y[2] * t0[3] + y[3] * t0[2]}; }
                            { const f32x4 y = v[bj][1]; v[bj][1] = (f32x4){y[0] * t1[0] - y[1] * t1[1], y[0] * t1[1] + y[1] * t1[0], y[2] * t1[2] - y[3] * t1[3], y[2] * t1[3] + y[3] * t1[2]}; }
                        }
                    }
                }
                bf16_t* rowp = base + (unsigned)(R * 64);
#pragma unroll
                for (int bj = 0; bj < 2; ++bj) { const f32x4 v0 = v[bj][0] * qs, v1 = v[bj][1] * qs;
                    u32x4 w; w.x = cvt_pk_bf16(v0[0], v0[1]); w.y = cvt_pk_bf16(v0[2], v0[3]); w.z = cvt_pk_bf16(v1[0], v1[1]); w.w = cvt_pk_bf16(v1[2], v1[3]);
                    *(u32x4*)(rowp + 32 * bj) = w; }
                asm volatile("" ::: "memory");
            }
    }
};
struct EpiGateRes {
    static constexpr bool PERM = true, AFTER_DRAIN = false, AMAP = false;
    const float* base_lat; const float* base_ctx; float* out_lat; float* out_ctx; const float* gate; int gate_stride; int row_off;
    __device__ __forceinline__ void operator()(const f32x4 (&acc)[2][2][4][2], const Unit& u, int wr, int wc, int fr, int fq) const {
        asm volatile("" : "+v"(fr), "+v"(fq));
        const int r0 = row_off + u.pm * BM;
        const bool lat = r0 < P_LAT_ROWS;
        const int brow = lat ? (r0 >> 12) : 8;
        const float* bp = lat ? base_lat + (size_t)r0 * 1024 : base_ctx + (size_t)(r0 - P_LAT_ROWS) * 1024;
        float* op = lat ? out_lat + (size_t)r0 * 1024 : out_ctx + (size_t)(r0 - P_LAT_ROWS) * 1024;
        const int col0 = u.pn * BM + wc * 32 + 8 * fq;
        f32x4 gv[2][2];
#pragma unroll
        for (int bj = 0; bj < 2; ++bj)
#pragma unroll
            for (int n = 0; n < 2; ++n) gv[bj][n] = *(const f32x4*)(gate + (size_t)brow * gate_stride + col0 + bj * HALF + 4 * n);
#pragma unroll
        for (int ai = 0; ai < 2; ++ai)
#pragma unroll
            for (int m = 0; m < 4; ++m) { const unsigned off = (unsigned)(ai * HALF + wr * 64 + m * 16 + fr) * 1024u + (unsigned)col0;
#pragma unroll
                for (int bj = 0; bj < 2; ++bj)
#pragma unroll
                    for (int n = 0; n < 2; ++n) { const f32x4 bs = *(const f32x4*)(bp + off + bj * HALF + 4 * n);
                        *(f32x4*)(op + off + bj * HALF + 4 * n) = bs + gv[bj][n] * acc[ai][bj][m][n]; }
                asm volatile("" ::: "memory"); }
    }
};
struct EpiConv {
    static constexpr bool PERM = true, AFTER_DRAIN = false, AMAP = true;
    bf16_t* ACTp; float* SB; const float* cw; const float* cb;
    __device__ __forceinline__ void operator()(const f32x4 (&acc)[2][2][4][2], const Unit& u, int wr, int wc, int fr, int fq) const {
        asm volatile("" : "+v"(fr), "+v"(fq));
        typedef unsigned u32x2c __attribute__((ext_vector_type(2)));
        const int j0 = u.pn * 128 + wc * 32 + 8 * fq, rowbase = u.pm * BM;
        u32x2c keep[2][4];
#pragma unroll
        for (int n = 0; n < 2; ++n) {
            const int j = j0 + 4 * n;
            const f32x4 wu0 = *(const f32x4*)(cw + j), wu1 = *(const f32x4*)(cw + 5632 + j), wu2 = *(const f32x4*)(cw + 2 * 5632 + j), bu = *(const f32x4*)(cb + j);
            const f32x4 wg0 = *(const f32x4*)(cw + 2816 + j), wg1 = *(const f32x4*)(cw + 5632 + 2816 + j), wg2 = *(const f32x4*)(cw + 2 * 5632 + 2816 + j), bg = *(const f32x4*)(cb + 2816 + j);
#pragma unroll
            for (int ai = 0; ai < 2; ++ai) {
                const int row0 = rowbase + ai * HALF + wr * 64, seg = row0 >> 6;
                f32x4 Up, Un, Gp, Gn;
#pragma unroll
                for (int c = 0; c < 4; ++c) {
                    Up[c] = __int_as_float(__builtin_amdgcn_update_dpp(__float_as_int(acc[ai][0][3][n][c]), __float_as_int(acc[ai][0][3][n][c]), 0x111, 0xf, 0xf, false));
                    Un[c] = __int_as_float(__builtin_amdgcn_update_dpp(__float_as_int(acc[ai][0][0][n][c]), __float_as_int(acc[ai][0][0][n][c]), 0x101, 0xf, 0xf, false));
                    Gp[c] = __int_as_float(__builtin_amdgcn_update_dpp(__float_as_int(acc[ai][1][3][n][c]), __float_as_int(acc[ai][1][3][n][c]), 0x111, 0xf, 0xf, false));
                    Gn[c] = __int_as_float(__builtin_amdgcn_update_dpp(__float_as_int(acc[ai][1][0][n][c]), __float_as_int(acc[ai][1][0][n][c]), 0x101, 0xf, 0xf, false)); }
#pragma unroll
                for (int m = 0; m < 4; ++m) {
                    const f32x4 pu = m ? acc[ai][0][m ? m - 1 : 0][n] : Up, nu = (m < 3) ? acc[ai][0][m < 3 ? m + 1 : 3][n] : Un;
                    const f32x4 pg = m ? acc[ai][1][m ? m - 1 : 0][n] : Gp, ng = (m < 3) ? acc[ai][1][m < 3 ? m + 1 : 3][n] : Gn;
                    const f32x4 cu = pu * wu0 + acc[ai][0][m][n] * wu1 + nu * wu2 + bu;
                    const f32x4 cgv = pg * wg0 + acc[ai][1][m][n] * wg1 + ng * wg2 + bg;
                    f32x4 a;
#pragma unroll
                    for (int c = 0; c < 4; ++c) a[c] = (cgv[c] * cu[c]) * __builtin_amdgcn_rcpf(1.f + __builtin_amdgcn_exp2f(cgv[c] * -1.4426950408889634f));
                    u32x2c w; w.x = cvt_pk_bf16(a[0], a[1]); w.y = cvt_pk_bf16(a[2], a[3]);
                    if (n == 0) keep[ai][m] = w;
                    else { u32x4 w4; w4.x = keep[ai][m].x; w4.y = keep[ai][m].y; w4.z = w.x; w4.w = w.y;
                        *(u32x4*)(ACTp + (size_t)(row0 + 4 * fr + m) * 2816 + j0) = w4; }
                }
                if (fr == 0) { float* s = SB + (size_t)(seg * 4) * 5632 + j;
                    *(f32x4*)(s) = acc[ai][0][0][n]; *(f32x4*)(s + 2816) = acc[ai][1][0][n]; *(f32x4*)(s + 5632) = acc[ai][0][1][n]; *(f32x4*)(s + 5632 + 2816) = acc[ai][1][1][n]; }
                if (fr == 15) { float* s = SB + (size_t)(seg * 4 + 2) * 5632 + j;
                    *(f32x4*)(s) = acc[ai][0][2][n]; *(f32x4*)(s + 2816) = acc[ai][1][2][n]; *(f32x4*)(s + 5632) = acc[ai][0][3][n]; *(f32x4*)(s + 5632 + 2816) = acc[ai][1][3][n]; }
                asm volatile("" ::: "memory");
            }
        }
    }
};
template <class Epi, class Sched, bool ALIGN_EPI = false, bool SP2 = false>
__device__ __forceinline__ void gemm_phase(PG8_LAS unsigned char* lds, const Gemm g, const Sched& S, const Epi& E) {
    int tid_ = threadIdx.x; asm volatile("" : "+v"(tid_));
    const int tid = tid_, wid = __builtin_amdgcn_readfirstlane(tid >> 6), lane = tid & 63, wr = wid >> 2, wc = wid & 3, fr = lane & 15, fq = lane >> 4;
    const int K = g.K, nt = K / BK;
    unsigned voffA[2], voffB[2];
#pragma unroll
    for (int i = 0; i < 2; ++i) { int R, C; stage_rc(tid * 16 + i * 8192, R, C); const int Rb = Epi::PERM ? ((R & ~31) + perm32(R & 31)) : R;
        const int Ra = Epi::AMAP ? ((R & 64) | ((R & 15) << 2) | ((R >> 4) & 3)) : R;
        voffA[i] = (unsigned)(Ra * K + C) * 2u; voffB[i] = (unsigned)(Rb * K + C) * 2u; }
    const size_t kstep = (size_t)(BK * 2);
    const size_t hstep = (size_t)HALF * K * 2;
    const size_t tstep = 2 * hstep;
    const unsigned ldsw = (unsigned)wid * 1024u;
    const int aoff = lds_byte(wr * 64 + fr, fq * 8), boff = lds_byte(wc * 32 + fr, fq * 8);
#define PG8_SA(b, h) (((b) * 2 + (h)) * HTB)
#define PG8_SB(b, h) ((4 + (b) * 2 + (h)) * HTB)
#define PG8_STAGE(bufoff, gbase, voff) do { _Pragma("unroll") for (int _i = 0; _i < 2; ++_i) \
        __builtin_amdgcn_global_load_lds((const unsigned*)((const char*)(gbase) + (voff)[_i]), (PG8_LAS unsigned*)(lds + (bufoff) + ldsw + _i * 8192), 16, 0, 0); } while (0)
#define PG8_LDA(dst, b, h) do { _Pragma("unroll") for (int m = 0; m < 4; ++m) _Pragma("unroll") for (int k = 0; k < 2; ++k) dst[m][k] = *(const PG8_LAS bf16x8*)(lds + PG8_SA(b, h) + aoff + m * 2048 + k * 1024); } while (0)
#define PG8_LDB(dst, b, h) do { _Pragma("unroll") for (int n = 0; n < 2; ++n) _Pragma("unroll") for (int k = 0; k < 2; ++k) dst[n][k] = *(const PG8_LAS bf16x8*)(lds + PG8_SB(b, h) + boff + n * 2048 + k * 1024); } while (0)
#define PG8_MMA(ai, bj, At, Bt) do { __builtin_amdgcn_s_setprio(1); _Pragma("unroll") for (int m = 0; m < 4; ++m) _Pragma("unroll") for (int n = 0; n < 2; ++n) _Pragma("unroll") for (int k = 0; k < 2; ++k) \
        acc[ai][bj][m][n] = __builtin_amdgcn_mfma_f32_16x16x32_bf16(Bt[n][k], At[m][k], acc[ai][bj][m][n], 0, 0, 0); __builtin_amdgcn_s_setprio(0); } while (0)
#define PG8_WAIT_V(n) asm volatile("s_waitcnt vmcnt(" #n ")" ::: "memory")
#define PG8_WAIT_L(n) asm volatile("s_waitcnt lgkmcnt(" #n ")" ::: "memory")
#define PG8_BAR __builtin_amdgcn_s_barrier()
#define PG8_SCHED __builtin_amdgcn_sched_barrier(0)
    Unit cur, nxt; int ui = 0;
    if (!S.next(0, cur)) return;
    f32x4 acc[2][2][4][2];
#pragma unroll
    for (int a = 0; a < 2; ++a)
#pragma unroll
        for (int b = 0; b < 2; ++b)
#pragma unroll
            for (int m = 0; m < 4; ++m)
#pragma unroll
                for (int n = 0; n < 2; ++n) acc[a][b][m][n] = (f32x4){0.f, 0.f, 0.f, 0.f};
    bf16x8 At[4][2], B0[2][2], B1[2][2];
    const char* cA = (const char*)g.A + (size_t)cur.pm * tstep; const char* cB = (const char*)g.Bt + (size_t)cur.pn * tstep;
    S.a_ready(cur);
    if constexpr (SP2) {
        PG8_STAGE(PG8_SB(0, 0), cB, voffB); PG8_STAGE(PG8_SB(0, 1), cB + hstep, voffB); PG8_STAGE(PG8_SA(0, 0), cA, voffA); PG8_STAGE(PG8_SA(0, 1), cA + hstep, voffA);
        if (wr == 1) PG8_BAR;
        PG8_WAIT_V(2); PG8_BAR;
        PG8_STAGE(PG8_SB(1, 0), cB + kstep, voffB); PG8_STAGE(PG8_SA(1, 0), cA + kstep, voffA); PG8_STAGE(PG8_SB(1, 1), cB + hstep + kstep, voffB);
        PG8_WAIT_V(6); PG8_BAR;
    } else {
        PG8_STAGE(PG8_SB(0, 0), cB, voffB); PG8_STAGE(PG8_SA(0, 0), cA, voffA); PG8_STAGE(PG8_SB(0, 1), cB + hstep, voffB); PG8_STAGE(PG8_SA(0, 1), cA + hstep, voffA);
        if (wr == 1) PG8_BAR;
        PG8_WAIT_V(4); PG8_BAR;
        PG8_STAGE(PG8_SB(1, 0), cB + kstep, voffB); PG8_STAGE(PG8_SA(1, 0), cA + kstep, voffA); PG8_STAGE(PG8_SB(1, 1), cB + hstep + kstep, voffB);
        PG8_WAIT_V(6); PG8_BAR;
    }
    for (;;) {
        const bool has_next = S.next(ui + 1, nxt);
        const char* nA = has_next ? (const char*)g.A + (size_t)nxt.pm * tstep : cA; const char* nB = has_next ? (const char*)g.Bt + (size_t)nxt.pn * tstep : cB;
        for (int t = 0; t < nt; t += 2) {
            const bool last = (t == nt - 2);
            const char* a1 = cA + (size_t)(t + 1) * kstep;
            const char* a2 = last ? nA : cA + (size_t)(t + 2) * kstep; const char* b2 = last ? nB : cB + (size_t)(t + 2) * kstep;
            const char* a3 = a2 + kstep; const char* b3 = b2 + kstep;
            if (last && has_next) S.a_ready(nxt);
            if constexpr (SP2) {
            PG8_LDB(B0, 0, 0); PG8_LDB(B1, 0, 1); PG8_SCHED; PG8_LDA(At, 0, 0); PG8_STAGE(PG8_SA(1, 1), a1 + hstep, voffA);
            PG8_WAIT_V(8); PG8_WAIT_L(0); PG8_BAR; PG8_MMA(0, 0, At, B0); PG8_MMA(0, 1, At, B1); PG8_BAR; PG8_SCHED;
            PG8_LDA(At, 0, 1); PG8_STAGE(PG8_SB(0, 0), b2, voffB); PG8_STAGE(PG8_SB(0, 1), b2 + hstep, voffB); PG8_STAGE(PG8_SA(0, 0), a2, voffA);
            PG8_WAIT_V(8); PG8_WAIT_L(0); PG8_BAR; PG8_MMA(1, 0, At, B0); PG8_MMA(1, 1, At, B1); PG8_BAR; PG8_SCHED;
            PG8_LDB(B0, 1, 0); PG8_LDB(B1, 1, 1); PG8_SCHED; PG8_LDA(At, 1, 0); PG8_STAGE(PG8_SA(0, 1), a2 + hstep, voffA);
            PG8_WAIT_V(8); PG8_WAIT_L(0); PG8_BAR; PG8_MMA(0, 0, At, B0); PG8_MMA(0, 1, At, B1); PG8_BAR; PG8_SCHED;
            PG8_LDA(At, 1, 1); PG8_STAGE(PG8_SB(1, 0), b3, voffB); PG8_STAGE(PG8_SB(1, 1), b3 + hstep, voffB); PG8_STAGE(PG8_SA(1, 0), a3, voffA);
            PG8_WAIT_V(8); PG8_WAIT_L(0); PG8_BAR; PG8_MMA(1, 0, At, B0); PG8_MMA(1, 1, At, B1); PG8_BAR; PG8_SCHED;
            } else {
            PG8_LDB(B0, 0, 0); PG8_SCHED; PG8_LDA(At, 0, 0); PG8_STAGE(PG8_SA(1, 1), a1 + hstep, voffA);
            PG8_WAIT_L(8); PG8_BAR; PG8_WAIT_L(0); PG8_MMA(0, 0, At, B0); PG8_BAR; PG8_SCHED;
            PG8_LDB(B1, 0, 1); PG8_STAGE(PG8_SB(0, 0), b2, voffB);
            PG8_BAR; PG8_WAIT_L(0); PG8_MMA(0, 1, At, B1); PG8_BAR;
            PG8_LDA(At, 0, 1); PG8_STAGE(PG8_SA(0, 0), a2, voffA);
            PG8_BAR; PG8_WAIT_L(0); PG8_MMA(1, 0, At, B0); PG8_BAR; PG8_SCHED;
            PG8_STAGE(PG8_SB(0, 1), b2 + hstep, voffB);
            PG8_WAIT_V(6); PG8_BAR; PG8_MMA(1, 1, At, B1); PG8_BAR;
            PG8_LDB(B0, 1, 0); PG8_SCHED; PG8_LDA(At, 1, 0); PG8_STAGE(PG8_SA(0, 1), a2 + hstep, voffA);
            PG8_WAIT_L(8); PG8_BAR; PG8_WAIT_L(0); PG8_MMA(0, 0, At, B0); PG8_BAR; PG8_SCHED;
            PG8_LDB(B1, 1, 1); PG8_STAGE(PG8_SB(1, 0), b3, voffB);
            PG8_BAR; PG8_WAIT_L(0); PG8_MMA(0, 1, At, B1); PG8_BAR;
            PG8_LDA(At, 1, 1); PG8_STAGE(PG8_SA(1, 0), a3, voffA);
            PG8_BAR; PG8_WAIT_L(0); PG8_MMA(1, 0, At, B0); PG8_BAR; PG8_SCHED;
            PG8_STAGE(PG8_SB(1, 1), b3 + hstep, voffB);
            PG8_WAIT_V(6); PG8_BAR; PG8_MMA(1, 1, At, B1); PG8_BAR;
            }
        }
        if constexpr (ALIGN_EPI) { if (wr == 0) PG8_BAR; }
        if constexpr (!Epi::AFTER_DRAIN) { E(acc, cur, wr, wc, fr, fq); S.done(cur); }
        if (!has_next) break;
#pragma unroll
        for (int a = 0; a < 2; ++a)
#pragma unroll
            for (int b = 0; b < 2; ++b)
#pragma unroll
                for (int m = 0; m < 4; ++m)
#pragma unroll
                    for (int n = 0; n < 2; ++n) acc[a][b][m][n] = (f32x4){0.f, 0.f, 0.f, 0.f};
        cur = nxt; cA = nA; cB = nB; ++ui;
        if constexpr (ALIGN_EPI) { if (wr == 1) PG8_BAR; }
    }
    PG8_WAIT_V(0);
    if constexpr (!ALIGN_EPI) { if (wr == 0) PG8_BAR; }
    PG8_BAR;
    if constexpr (Epi::AFTER_DRAIN) { E.fused(acc, cur, wr, wc, fr, fq, lds, wid, lane); S.done(cur); }
#undef PG8_SA
#undef PG8_SB
#undef PG8_STAGE
#undef PG8_LDA
#undef PG8_LDB
#undef PG8_MMA
#undef PG8_WAIT_V
#undef PG8_WAIT_L
#undef PG8_BAR
#undef PG8_SCHED
}
}
namespace att {
#define ATT_LAS __attribute__((address_space(3)))
typedef unsigned short bf16_t;
typedef short bf16x8 __attribute__((ext_vector_type(8)));
typedef float f32x16 __attribute__((ext_vector_type(16)));
typedef float f32x2 __attribute__((ext_vector_type(2)));
typedef __bf16 bf16x2v __attribute__((ext_vector_type(2)));
typedef unsigned u32x4 __attribute__((ext_vector_type(4)));
typedef unsigned u32x2 __attribute__((ext_vector_type(2)));
constexpr int ST = 4352, NSLOT = 36, SEQ = 4096, LAT_ROWS = 32768;
constexpr int RS = 144;
constexpr int TILE_B = 64 * RS;
constexpr int KV_B = 2 * TILE_B;
constexpr int STAGE_B = 2 * KV_B;
constexpr int LDS_RPB = 2 * STAGE_B;
constexpr int LDS_BYTES = LDS_RPB + 2048;
constexpr float THR = 8.0f;
#define MFMA32(a, b, c) __builtin_amdgcn_mfma_f32_32x32x16_bf16((a), (b), (c), 0, 0, 0)
__device__ __forceinline__ unsigned pk(float lo, float hi) { f32x2 v = {lo, hi}; bf16x2v b = __builtin_convertvector(v, bf16x2v); return __builtin_bit_cast(unsigned, b); }
__device__ __forceinline__ float ex2(float x) { return __builtin_amdgcn_exp2f(x); }
__device__ __forceinline__ float mx3(float a, float b, float c) { return __builtin_fmaxf(__builtin_fmaxf(a, b), c); }
__device__ __forceinline__ float xsum32(float v) { const auto rr = __builtin_amdgcn_permlane32_swap(__float_as_uint(v), __float_as_uint(v), false, false); return __uint_as_float(rr[0]) + __uint_as_float(rr[1]); }

struct Params { const bf16_t* QKV; bf16_t* O; const float* rpb; const float* gsub; float lam; float one_m_lam_init; };
struct Mask { const ATT_LAS float* rpbl; int brow, cs, qc; };

template <int DS0, int NDS, bool MASK, bool USE_NEGM, bool V_EARLY, int ABL, bool FX = false>
__device__ __forceinline__ void tile_step(const ATT_LAS unsigned char* Ks, const ATT_LAS unsigned char* Vs, const bf16x8 (&qf)[4], int prow, int r, int h,
                                          float& m, float& l, f32x16 (&o)[2], f32x16& negm, bool first, const Mask& mk) {
    bf16x8 ka[NDS], kb[NDS], va[4], vb[4];
#pragma unroll
    for (int d = 0; d < NDS; ++d) {
        ka[d] = *(const ATT_LAS bf16x8*)(Ks + prow * RS + (16 * (DS0 + d) + 8 * h) * 2);
        kb[d] = *(const ATT_LAS bf16x8*)(Ks + (32 + prow) * RS + (16 * (DS0 + d) + 8 * h) * 2);
    }
    if (V_EARLY) {
#pragma unroll
        for (int ks = 0; ks < 4; ++ks) {
            va[ks] = *(const ATT_LAS bf16x8*)(Vs + r * RS + (16 * ks + 8 * h) * 2);
            vb[ks] = *(const ATT_LAS bf16x8*)(Vs + (32 + r) * RS + (16 * ks + 8 * h) * 2);
        }
    }
    f32x16 x0, x1;
    if (ABL == 2) { x0 = negm; x1 = negm; _Pragma("unroll") for (int i = 0; i < 16; ++i) { x0[i] += __builtin_bit_cast(float, (int)ka[0][i & 7]) * 1e-30f; x1[i] += __builtin_bit_cast(float, (int)kb[NDS - 1][i & 7]) * 1e-30f; } } else
    if (USE_NEGM) { x0 = MFMA32(ka[0], qf[DS0], negm); x1 = MFMA32(kb[0], qf[DS0], negm); }
    else { f32x16 z; _Pragma("unroll") for (int i = 0; i < 16; ++i) z[i] = 0.f; x0 = MFMA32(ka[0], qf[DS0], z); x1 = MFMA32(kb[0], qf[DS0], z); }
    if (ABL != 2) {
#pragma unroll
    for (int d = 1; d < NDS; ++d) { x0 = MFMA32(ka[d], qf[DS0 + d], x0); x1 = MFMA32(kb[d], qf[DS0 + d], x1); }
    }
    if (!USE_NEGM && !FX) {
#pragma unroll
        for (int i = 0; i < 16; ++i) { x0[i] -= m; x1[i] -= m; }
    }
    if (MASK) {
        int t = 8 * h - mk.cs, u = mk.brow + 8 * h - mk.qc + 15;
        asm volatile("" : "+v"(t), "+v"(u));
        const ATT_LAS float* bp = mk.rpbl + u;
#pragma unroll
        for (int i = 0; i < 16; ++i) {
            const int c0 = 16 * (i >> 3) + (i & 7);
            const bool ok0 = (unsigned)(c0 + t) < 16u, ok1 = (unsigned)(c0 + 32 + t) < 16u;
            const float b0 = bp[c0], b1 = bp[c0 + 32];
            x0[i] = ok0 ? x0[i] + b0 : -INFINITY; x1[i] = ok1 ? x1[i] + b1 : -INFINITY;
        }
    }
    if (ABL != 1) {
    if (FX) __builtin_amdgcn_sched_barrier(0);
    if (!FX) {
    float ma = mx3(x0[0], x0[1], x1[0]), mb = mx3(x0[2], x0[3], x1[1]);
    ma = mx3(ma, x1[2], x1[3]);
#pragma unroll
    for (int i = 4; i < 16; i += 4) { ma = mx3(ma, x0[i], x0[i + 1]); mb = mx3(mb, x0[i + 2], x0[i + 3]); ma = mx3(ma, x1[i], x1[i + 1]); mb = mx3(mb, x1[i + 2], x1[i + 3]); }
    float mt = __builtin_fmaxf(ma, mb);
    { const auto rr = __builtin_amdgcn_permlane32_swap(__float_as_uint(mt), __float_as_uint(mt), false, false); mt = __builtin_fmaxf(__uint_as_float(rr[0]), __uint_as_float(rr[1])); }
    if (first || __any(mt > THR)) {
        const float dl = first ? mt : __builtin_fmaxf(mt, 0.f);
        m += dl;
#pragma unroll
        for (int i = 0; i < 16; ++i) { x0[i] -= dl; x1[i] -= dl; }
        if (!first) {
            const float f = ex2(-dl);
            l *= f;
#pragma unroll
            for (int i = 0; i < 16; ++i) { o[0][i] *= f; o[1][i] *= f; }
        }
        if (USE_NEGM) {
#pragma unroll
            for (int i = 0; i < 16; ++i) negm[i] = -m;
        }
    }
    }
    if (!V_EARLY) {
#pragma unroll
        for (int ks = 0; ks < 4; ++ks) {
            va[ks] = *(const ATT_LAS bf16x8*)(Vs + r * RS + (16 * ks + 8 * h) * 2);
            vb[ks] = *(const ATT_LAS bf16x8*)(Vs + (32 + r) * RS + (16 * ks + 8 * h) * 2);
        }
    }
    float s0 = 0.f, s1 = 0.f;
#pragma unroll
    for (int i = 0; i < 16; ++i) { x0[i] = ex2(x0[i]); s0 += x0[i]; }
#pragma unroll
    for (int i = 0; i < 16; ++i) { x1[i] = ex2(x1[i]); s1 += x1[i]; }
    l += s0 + s1;
    } else { l += x0[0] + x1[5]; }
    bf16x8 pb[2][2];
    { u32x4 w;
      w.x = pk(x0[0], x0[1]); w.y = pk(x0[2], x0[3]); w.z = pk(x0[4], x0[5]); w.w = pk(x0[6], x0[7]); pb[0][0] = __builtin_bit_cast(bf16x8, w);
      w.x = pk(x0[8], x0[9]); w.y = pk(x0[10], x0[11]); w.z = pk(x0[12], x0[13]); w.w = pk(x0[14], x0[15]); pb[0][1] = __builtin_bit_cast(bf16x8, w);
      w.x = pk(x1[0], x1[1]); w.y = pk(x1[2], x1[3]); w.z = pk(x1[4], x1[5]); w.w = pk(x1[6], x1[7]); pb[1][0] = __builtin_bit_cast(bf16x8, w);
      w.x = pk(x1[8], x1[9]); w.y = pk(x1[10], x1[11]); w.z = pk(x1[12], x1[13]); w.w = pk(x1[14], x1[15]); pb[1][1] = __builtin_bit_cast(bf16x8, w); }
    if (ABL == 2) {
#pragma unroll
        for (int kt = 0; kt < 2; ++kt)
#pragma unroll
            for (int s = 0; s < 2; ++s) { o[0][kt * 2 + s] += __builtin_bit_cast(float, (int)(va[2 * kt + s][0] ^ pb[kt][s][1])); o[1][kt * 2 + s] += __builtin_bit_cast(float, (int)(vb[2 * kt + s][3] ^ pb[kt][s][2])); }
    } else {
#pragma unroll
    for (int kt = 0; kt < 2; ++kt)
#pragma unroll
        for (int s = 0; s < 2; ++s) { o[0] = MFMA32(va[2 * kt + s], pb[kt][s], o[0]); o[1] = MFMA32(vb[2 * kt + s], pb[kt][s], o[1]); }
    }
}

__device__ __forceinline__ void tile_step_diff_fx(const ATT_LAS unsigned char* Ks, const ATT_LAS unsigned char* Vs, const bf16x8 (&qf)[4], int prow, int r, int h,
                                                  float& l1, f32x16 (&o1)[2], float& l2, f32x16 (&o2)[2]) {
    bf16x8 va[4], vb[4];
#pragma unroll
    for (int ks = 0; ks < 4; ++ks) { va[ks] = *(const ATT_LAS bf16x8*)(Vs + r * RS + (16 * ks + 8 * h) * 2); vb[ks] = *(const ATT_LAS bf16x8*)(Vs + (32 + r) * RS + (16 * ks + 8 * h) * 2); }
#pragma unroll
    for (int mp = 0; mp < 2; ++mp) {
        f32x16 z;
#pragma unroll
        for (int i = 0; i < 16; ++i) z[i] = 0.f;
        const bf16x8 ka0 = *(const ATT_LAS bf16x8*)(Ks + prow * RS + (16 * (2 * mp) + 8 * h) * 2), kb0 = *(const ATT_LAS bf16x8*)(Ks + (32 + prow) * RS + (16 * (2 * mp) + 8 * h) * 2);
        const bf16x8 ka1 = *(const ATT_LAS bf16x8*)(Ks + prow * RS + (16 * (2 * mp + 1) + 8 * h) * 2), kb1 = *(const ATT_LAS bf16x8*)(Ks + (32 + prow) * RS + (16 * (2 * mp + 1) + 8 * h) * 2);
        f32x16 x0 = MFMA32(ka0, qf[2 * mp], z), x1 = MFMA32(kb0, qf[2 * mp], z);
        x0 = MFMA32(ka1, qf[2 * mp + 1], x0); x1 = MFMA32(kb1, qf[2 * mp + 1], x1);
        float s0 = 0.f, s1 = 0.f;
#pragma unroll
        for (int i = 0; i < 16; ++i) { x0[i] = ex2(x0[i]); s0 += x0[i]; }
#pragma unroll
        for (int i = 0; i < 16; ++i) { x1[i] = ex2(x1[i]); s1 += x1[i]; }
        if (mp == 0) l1 += s0 + s1; else l2 += s0 + s1;
        bf16x8 pb[4];
        { u32x4 w;
          w.x = pk(x0[0], x0[1]); w.y = pk(x0[2], x0[3]); w.z = pk(x0[4], x0[5]); w.w = pk(x0[6], x0[7]); pb[0] = __builtin_bit_cast(bf16x8, w);
          w.x = pk(x0[8], x0[9]); w.y = pk(x0[10], x0[11]); w.z = pk(x0[12], x0[13]); w.w = pk(x0[14], x0[15]); pb[1] = __builtin_bit_cast(bf16x8, w);
          w.x = pk(x1[0], x1[1]); w.y = pk(x1[2], x1[3]); w.z = pk(x1[4], x1[5]); w.w = pk(x1[6], x1[7]); pb[2] = __builtin_bit_cast(bf16x8, w);
          w.x = pk(x1[8], x1[9]); w.y = pk(x1[10], x1[11]); w.z = pk(x1[12], x1[13]); w.w = pk(x1[14], x1[15]); pb[3] = __builtin_bit_cast(bf16x8, w); }
        if (mp == 0) {
#pragma unroll
            for (int ks = 0; ks < 4; ++ks) { o1[0] = MFMA32(va[ks], pb[ks], o1[0]); o1[1] = MFMA32(vb[ks], pb[ks], o1[1]); }
        } else {
#pragma unroll
            for (int ks = 0; ks < 4; ++ks) { o2[0] = MFMA32(va[ks], pb[ks], o2[0]); o2[1] = MFMA32(vb[ks], pb[ks], o2[1]); }
        }
    }
}

template <int TYPE, int ABL = 0, bool FX = false>
__device__ __forceinline__ void unit(const Params& P, ATT_LAS unsigned char* lds, int b, int qslot, int kslot, int vslot, int q_tok0, int t0, int nt, int ocol, int bhead) {
    int tid_ = threadIdx.x; asm volatile("" : "+v"(tid_));
    const int tid = tid_, lane = tid & 63, r = lane & 31, h = lane >> 5, wid = __builtin_amdgcn_readfirstlane(tid >> 6);
    const bf16_t* Qp = P.QKV + ((size_t)(b * NSLOT + qslot) * ST + q_tok0 + wid * 32 + r) * 64;
    const bf16_t* Kp = P.QKV + (size_t)(b * NSLOT + kslot) * ST * 64;
    const bf16_t* Vp = P.QKV + (size_t)(b * NSLOT + vslot) * ST * 64;
    bf16x8 qf[4];
#pragma unroll
    for (int ds = 0; ds < 4; ++ds) qf[ds] = *(const bf16x8*)(Qp + 16 * ds + 8 * h);
    int kr0 = 0, nb = 0, qr = 0, rsw = 0;
    Mask mk; mk.rpbl = (const ATT_LAS float*)(lds + LDS_RPB); mk.brow = 0; mk.cs = 0; mk.qc = 0;
    if (TYPE == 2) {
        const int R0 = q_tok0 >> 6;
        const int rsa = min(max(R0 - 4, 0), 56), rsb = min(max(R0 + 3 - 4, 0), 56);
        kr0 = rsa; nb = rsb + 8 - rsa; nt = nb + 4;
        qr = R0 + (wid >> 1); mk.qc = 32 * (wid & 1) + r;
        rsw = min(max(qr - 4, 0), 56); mk.cs = min(max(mk.qc - 8, 0), 48);
        ATT_LAS float* rw = (ATT_LAS float*)(lds + LDS_RPB);
        for (int i = tid; i < 465; i += 512) rw[i] = P.rpb[bhead * 465 + i] * 1.4426950408889634f;
    }
    const int kkey = tid >> 3, kch = tid & 7;
    const int vkey = tid & 63, vch = tid >> 6;
#define ATT_KEY_BASE(j) ((TYPE == 2) ? (((j) < nb) ? 64 * (kr0 + (j)) : SEQ + 64 * ((j) - nb)) : 64 * (t0 + (j)))
#define ATT_LOAD(i, j) do { const int kb_ = ATT_KEY_BASE(j); kreg[i] = *(const u32x4*)(Kp + (size_t)(kb_ + kkey) * 64 + 8 * kch); vreg[i] = *(const u32x4*)(Vp + (size_t)(kb_ + vkey) * 64 + 8 * vch); } while (0)
    u32x4 kreg[2], vreg[2];
    ATT_LOAD(0, 0); if (1 < nt) ATT_LOAD(1, 1);
    float m1 = 0.f, l1 = 0.f, m2 = 0.f, l2 = 0.f;
    f32x16 o1[2], o2[2], negm1;
#pragma unroll
    for (int i = 0; i < 16; ++i) { o1[0][i] = 0.f; o1[1][i] = 0.f; o2[0][i] = 0.f; o2[1][i] = 0.f; negm1[i] = 0.f; }
    const int prow = (r & ~12) | ((r & 4) << 1) | ((r & 8) >> 1);
    bool first = true;
    for (int jp = 0; jp < nt; jp += 2) {
        ATT_LAS unsigned char* stg = lds + ((jp >> 1) & 1) * STAGE_B;
#pragma unroll
        for (int i = 0; i < 2; ++i) {
            if (ABL != 3 && jp + i < nt) {
                ATT_LAS unsigned char* Ks = stg + i * KV_B; ATT_LAS unsigned char* Vs = Ks + TILE_B;
                *(ATT_LAS u32x4*)(Ks + kkey * RS + kch * 16) = kreg[i];
                ATT_LAS unsigned short* vd = (ATT_LAS unsigned short*)(Vs + (8 * vch) * RS + vkey * 2);
                vd[0 * (RS / 2)] = (unsigned short)(vreg[i].x & 0xffffu); vd[1 * (RS / 2)] = (unsigned short)(vreg[i].x >> 16);
                vd[2 * (RS / 2)] = (unsigned short)(vreg[i].y & 0xffffu); vd[3 * (RS / 2)] = (unsigned short)(vreg[i].y >> 16);
                vd[4 * (RS / 2)] = (unsigned short)(vreg[i].z & 0xffffu); vd[5 * (RS / 2)] = (unsigned short)(vreg[i].z >> 16);
                vd[6 * (RS / 2)] = (unsigned short)(vreg[i].w & 0xffffu); vd[7 * (RS / 2)] = (unsigned short)(vreg[i].w >> 16);
            }
        }
        __syncthreads();
        if (ABL != 4 && jp + 2 < nt) ATT_LOAD(0, jp + 2);
        if (ABL != 4 && jp + 3 < nt) ATT_LOAD(1, jp + 3);
        if (FX) {
#pragma unroll 1
        for (int i = 0; i < 2; ++i) {
            const int j = jp + i;
            if (j >= nt) break;
            const ATT_LAS unsigned char* Ks = stg + i * KV_B; const ATT_LAS unsigned char* Vs = Ks + TILE_B;
            if (TYPE == 2) {
                if (j < nb) {
                    const int kr = kr0 + j;
                    if ((kr >= rsw) && (kr < rsw + 8)) { mk.brow = (kr - qr + 7) * 31; tile_step<0, 4, true, false, false, ABL>(Ks, Vs, qf, prow, r, h, m1, l1, o1, negm1, first, mk); first = false; }
                } else { tile_step<0, 4, false, false, false, ABL>(Ks, Vs, qf, prow, r, h, m1, l1, o1, negm1, first, mk); first = false; }
            } else if (TYPE == 1) {
                tile_step_diff_fx(Ks, Vs, qf, prow, r, h, l1, o1, l2, o2);
                first = false;
            } else { tile_step<0, 4, false, true, true, ABL>(Ks, Vs, qf, prow, r, h, m1, l1, o1, negm1, first, mk); first = false; }
        }
        } else {
#pragma unroll
        for (int i = 0; i < 2; ++i) {
            const int j = jp + i;
            if (j >= nt) break;
            const ATT_LAS unsigned char* Ks = stg + i * KV_B; const ATT_LAS unsigned char* Vs = Ks + TILE_B;
            if (TYPE == 2) {
                if (j < nb) {
                    const int kr = kr0 + j;
                    if ((kr >= rsw) && (kr < rsw + 8)) { mk.brow = (kr - qr + 7) * 31; tile_step<0, 4, true, false, false, ABL>(Ks, Vs, qf, prow, r, h, m1, l1, o1, negm1, first, mk); first = false; }
                } else { tile_step<0, 4, false, false, false, ABL>(Ks, Vs, qf, prow, r, h, m1, l1, o1, negm1, first, mk); first = false; }
            } else if (TYPE == 1) {
                tile_step<0, 2, false, false, true, ABL, FX>(Ks, Vs, qf, prow, r, h, m1, l1, o1, negm1, first, mk);
                tile_step<2, 2, false, false, true, ABL, FX>(Ks, Vs, qf, prow, r, h, m2, l2, o2, negm1, first, mk);
                first = false;
            } else { tile_step<0, 4, false, true, true, ABL>(Ks, Vs, qf, prow, r, h, m1, l1, o1, negm1, first, mk); first = false; }
        }
        }
    }
    l1 = xsum32(l1);
    const float inv1 = 1.f / l1;
    f32x16 ov[2];
    if (TYPE == 1) {
        l2 = xsum32(l2);
        const float inv2 = P.lam / l2;
        float ss = 0.f;
#pragma unroll
        for (int dt = 0; dt < 2; ++dt)
#pragma unroll
            for (int i = 0; i < 16; ++i) { const float v = o1[dt][i] * inv1 - o2[dt][i] * inv2; ov[dt][i] = v; ss += v * v; }
        ss = xsum32(ss);
        const float rs = rsqrtf(ss * (1.f / 64.f) + 1e-6f) * P.one_m_lam_init;
#pragma unroll
        for (int dt = 0; dt < 2; ++dt)
#pragma unroll
            for (int i = 0; i < 16; ++i) ov[dt][i] = ov[dt][i] * rs * P.gsub[32 * dt + 8 * (i >> 2) + 4 * h + (i & 3)];
    } else {
#pragma unroll
        for (int dt = 0; dt < 2; ++dt)
#pragma unroll
            for (int i = 0; i < 16; ++i) ov[dt][i] = o1[dt][i] * inv1;
    }
    const int qtok = q_tok0 + wid * 32 + r;
    const size_t orow = (q_tok0 < SEQ) ? (size_t)b * SEQ + qtok : (size_t)LAT_ROWS + (size_t)b * 256 + (qtok - SEQ);
    bf16_t* op = P.O + orow * 1024 + ocol + 4 * h;
#pragma unroll
    for (int dt = 0; dt < 2; ++dt)
#pragma unroll
        for (int g = 0; g < 4; ++g) { u32x2 w; w.x = pk(ov[dt][4 * g], ov[dt][4 * g + 1]); w.y = pk(ov[dt][4 * g + 2], ov[dt][4 * g + 3]);
            *(u32x2*)(op + 32 * dt + 8 * g) = w; }
    __syncthreads();
#undef ATT_LOAD
#undef ATT_KEY_BASE
}

template <bool FX>
__device__ __forceinline__ void softmax64(f32x16& x0, f32x16& x1, float& m, float& l, f32x16 (&o)[2], bool first, bf16x8 (&pb)[4]) {
    if (!FX) {
    { float mone = -1.0f; asm volatile("" : "+v"(mone));
#pragma unroll
      for (int i = 0; i < 16; i += 2) { x0[i] -= m; x0[i + 1] = __builtin_fmaf(m, mone, x0[i + 1]); x1[i] = __builtin_fmaf(m, mone, x1[i]); x1[i + 1] -= m; } }
    float ma = mx3(x0[0], x0[1], x1[0]), mb = mx3(x0[2], x0[3], x1[1]);
    ma = mx3(ma, x1[2], x1[3]);
#pragma unroll
    for (int i = 4; i < 16; i += 4) { ma = mx3(ma, x0[i], x0[i + 1]); mb = mx3(mb, x0[i + 2], x0[i + 3]); ma = mx3(ma, x1[i], x1[i + 1]); mb = mx3(mb, x1[i + 2], x1[i + 3]); }
    float mt = __builtin_fmaxf(ma, mb);
    { const auto rr = __builtin_amdgcn_permlane32_swap(__float_as_uint(mt), __float_as_uint(mt), false, false); mt = __builtin_fmaxf(__uint_as_float(rr[0]), __uint_as_float(rr[1])); }
    if (first || __any(mt > THR)) {
        const float dl = first ? mt : __builtin_fmaxf(mt, 0.f);
        m += dl;
#pragma unroll
        for (int i = 0; i < 16; ++i) { x0[i] -= dl; x1[i] -= dl; }
        if (!first) {
            const float f = ex2(-dl);
            l *= f;
#pragma unroll
            for (int i = 0; i < 16; ++i) { o[0][i] *= f; o[1][i] *= f; }
        }
    }
    }
    { float one = 1.0f; asm volatile("" : "+v"(one));
      float sa = 0.f, sb = 0.f;
#pragma unroll
      for (int i = 0; i < 16; ++i) { x0[i] = ex2(x0[i]); x1[i] = ex2(x1[i]); sa += x0[i]; sb = __builtin_fmaf(x1[i], one, sb); }
      l += sa + sb; }
    u32x4 w;
    w.x = pk(x0[0], x0[1]); w.y = pk(x0[2], x0[3]); w.z = pk(x0[4], x0[5]); w.w = pk(x0[6], x0[7]); pb[0] = __builtin_bit_cast(bf16x8, w);
    w.x = pk(x0[8], x0[9]); w.y = pk(x0[10], x0[11]); w.z = pk(x0[12], x0[13]); w.w = pk(x0[14], x0[15]); pb[1] = __builtin_bit_cast(bf16x8, w);
    w.x = pk(x1[0], x1[1]); w.y = pk(x1[2], x1[3]); w.z = pk(x1[4], x1[5]); w.w = pk(x1[6], x1[7]); pb[2] = __builtin_bit_cast(bf16x8, w);
    w.x = pk(x1[8], x1[9]); w.y = pk(x1[10], x1[11]); w.z = pk(x1[12], x1[13]); w.w = pk(x1[14], x1[15]); pb[3] = __builtin_bit_cast(bf16x8, w);
}
template <bool FX>
__device__ __forceinline__ void unit64(const Params& P, ATT_LAS unsigned char* lds, int b, int qslot, int kslot, int vslot, int q_tok0, int nt, int ocol) {
    int tid_ = threadIdx.x; asm volatile("" : "+v"(tid_));
    const int tid = tid_, lane = tid & 63, r = lane & 31, h = lane >> 5, wid = __builtin_amdgcn_readfirstlane(tid >> 6);
    const bf16_t* Qp = P.QKV + ((size_t)(b * NSLOT + qslot) * ST + q_tok0 + wid * 64 + r) * 64;
    const bf16_t* Kp = P.QKV + (size_t)(b * NSLOT + kslot) * ST * 64;
    const bf16_t* Vp = P.QKV + (size_t)(b * NSLOT + vslot) * ST * 64;
    bf16x8 qA[4], qB[4];
#pragma unroll
    for (int ds = 0; ds < 4; ++ds) { qA[ds] = *(const bf16x8*)(Qp + 16 * ds + 8 * h); qB[ds] = *(const bf16x8*)(Qp + 32 * 64 + 16 * ds + 8 * h); }
    const int kkey = tid >> 3, kch = tid & 7, vkey = tid & 63, vch = tid >> 6;
#define U64_LOAD(i, j) do { const int kb_ = 64 * (j); kreg[i] = *(const u32x4*)(Kp + (size_t)(kb_ + kkey) * 64 + 8 * kch); vreg[i] = *(const u32x4*)(Vp + (size_t)(kb_ + vkey) * 64 + 8 * vch); } while (0)
    u32x4 kreg[2], vreg[2];
    U64_LOAD(0, 0); if (1 < nt) U64_LOAD(1, 1);
    float mA = 0.f, lA = 0.f, mB = 0.f, lB = 0.f;
    f32x16 oA[2], oB[2];
#pragma unroll
    for (int i = 0; i < 16; ++i) { oA[0][i] = 0.f; oA[1][i] = 0.f; oB[0][i] = 0.f; oB[1][i] = 0.f; }
    const int prow = (r & ~12) | ((r & 4) << 1) | ((r & 8) >> 1);
    bool first = true;
    for (int jp = 0; jp < nt; jp += 2) {
        ATT_LAS unsigned char* stg = lds + ((jp >> 1) & 1) * STAGE_B;
#pragma unroll
        for (int i = 0; i < 2; ++i) {
            if (jp + i < nt) {
                ATT_LAS unsigned char* Ks = stg + i * KV_B; ATT_LAS unsigned char* Vs = Ks + TILE_B;
                *(ATT_LAS u32x4*)(Ks + kkey * RS + kch * 16) = kreg[i];
                ATT_LAS unsigned short* vd = (ATT_LAS unsigned short*)(Vs + (8 * vch) * RS + vkey * 2);
                vd[0 * (RS / 2)] = (unsigned short)(vreg[i].x & 0xffffu); vd[1 * (RS / 2)] = (unsigned short)(vreg[i].x >> 16);
                vd[2 * (RS / 2)] = (unsigned short)(vreg[i].y & 0xffffu); vd[3 * (RS / 2)] = (unsigned short)(vreg[i].y >> 16);
                vd[4 * (RS / 2)] = (unsigned short)(vreg[i].z & 0xffffu); vd[5 * (RS / 2)] = (unsigned short)(vreg[i].z >> 16);
                vd[6 * (RS / 2)] = (unsigned short)(vreg[i].w & 0xffffu); vd[7 * (RS / 2)] = (unsigned short)(vreg[i].w >> 16);
            }
        }
        __syncthreads();
        if (jp + 2 < nt) U64_LOAD(0, jp + 2);
        if (jp + 3 < nt) U64_LOAD(1, jp + 3);
        if (FX) {
#pragma unroll 1
        for (int i = 0; i < 2; ++i) {
            if (jp + i >= nt) break;
            const ATT_LAS unsigned char* Ks = stg + i * KV_B; const ATT_LAS unsigned char* Vs = Ks + TILE_B;
            f32x16 xa0, xa1, xb0, xb1;
            { f32x16 z;
#pragma unroll
              for (int q = 0; q < 16; ++q) z[q] = 0.f;
#pragma unroll
              for (int d = 0; d < 4; ++d) {
                  const bf16x8 ka = *(const ATT_LAS bf16x8*)(Ks + prow * RS + (16 * d + 8 * h) * 2), kb = *(const ATT_LAS bf16x8*)(Ks + (32 + prow) * RS + (16 * d + 8 * h) * 2);
                  if (d == 0) { xa0 = MFMA32(ka, qA[0], z); xa1 = MFMA32(kb, qA[0], z); xb0 = MFMA32(ka, qB[0], z); xb1 = MFMA32(kb, qB[0], z); }
                  else { xa0 = MFMA32(ka, qA[d], xa0); xa1 = MFMA32(kb, qA[d], xa1); xb0 = MFMA32(ka, qB[d], xb0); xb1 = MFMA32(kb, qB[d], xb1); }
              } }
            bf16x8 pA[4], pB[4];
            if (FX) __builtin_amdgcn_sched_barrier(0);
            softmax64<FX>(xa0, xa1, mA, lA, oA, first, pA);
            if (FX) __builtin_amdgcn_sched_barrier(0);
            softmax64<FX>(xb0, xb1, mB, lB, oB, first, pB);
            if (FX) __builtin_amdgcn_sched_barrier(0);
            first = false;
#pragma unroll
            for (int ks = 0; ks < 4; ++ks) {
                const bf16x8 va = *(const ATT_LAS bf16x8*)(Vs + r * RS + (16 * ks + 8 * h) * 2), vb = *(const ATT_LAS bf16x8*)(Vs + (32 + r) * RS + (16 * ks + 8 * h) * 2);
                oA[0] = MFMA32(va, pA[ks], oA[0]); oA[1] = MFMA32(vb, pA[ks], oA[1]); oB[0] = MFMA32(va, pB[ks], oB[0]); oB[1] = MFMA32(vb, pB[ks], oB[1]);
            }
        }
        } else {
#pragma unroll
        for (int i = 0; i < 2; ++i) {
            if (jp + i >= nt) break;
            const ATT_LAS unsigned char* Ks = stg + i * KV_B; const ATT_LAS unsigned char* Vs = Ks + TILE_B;
            f32x16 xa0, xa1, xb0, xb1;
            { f32x16 z;
#pragma unroll
              for (int q = 0; q < 16; ++q) z[q] = 0.f;
#pragma unroll
              for (int d = 0; d < 4; ++d) {
                  const bf16x8 ka = *(const ATT_LAS bf16x8*)(Ks + prow * RS + (16 * d + 8 * h) * 2), kb = *(const ATT_LAS bf16x8*)(Ks + (32 + prow) * RS + (16 * d + 8 * h) * 2);
                  if (d == 0) { xa0 = MFMA32(ka, qA[0], z); xa1 = MFMA32(kb, qA[0], z); xb0 = MFMA32(ka, qB[0], z); xb1 = MFMA32(kb, qB[0], z); }
                  else { xa0 = MFMA32(ka, qA[d], xa0); xa1 = MFMA32(kb, qA[d], xa1); xb0 = MFMA32(ka, qB[d], xb0); xb1 = MFMA32(kb, qB[d], xb1); }
              } }
            bf16x8 pA[4], pB[4];
            if (FX) __builtin_amdgcn_sched_barrier(0);
            softmax64<FX>(xa0, xa1, mA, lA, oA, first, pA);
            if (FX) __builtin_amdgcn_sched_barrier(0);
            softmax64<FX>(xb0, xb1, mB, lB, oB, first, pB);
            if (FX) __builtin_amdgcn_sched_barrier(0);
            first = false;
#pragma unroll
            for (int ks = 0; ks < 4; ++ks) {
                const bf16x8 va = *(const ATT_LAS bf16x8*)(Vs + r * RS + (16 * ks + 8 * h) * 2), vb = *(const ATT_LAS bf16x8*)(Vs + (32 + r) * RS + (16 * ks + 8 * h) * 2);
                oA[0] = MFMA32(va, pA[ks], oA[0]); oA[1] = MFMA32(vb, pA[ks], oA[1]); oB[0] = MFMA32(va, pB[ks], oB[0]); oB[1] = MFMA32(vb, pB[ks], oB[1]);
            }
        }
        }
    }
    lA = xsum32(lA); lB = xsum32(lB);
    const float iA = 1.f / lA, iB = 1.f / lB;
    const size_t orow = (size_t)b * SEQ + q_tok0 + wid * 64 + r;
    bf16_t* op = P.O + orow * 1024 + ocol + 4 * h;
#pragma unroll
    for (int dt = 0; dt < 2; ++dt)
#pragma unroll
        for (int g = 0; g < 4; ++g) {
            u32x2 w; w.x = pk(oA[dt][4 * g] * iA, oA[dt][4 * g + 1] * iA); w.y = pk(oA[dt][4 * g + 2] * iA, oA[dt][4 * g + 3] * iA);
            *(u32x2*)(op + 32 * dt + 8 * g) = w;
            u32x2 v; v.x = pk(oB[dt][4 * g] * iB, oB[dt][4 * g + 1] * iB); v.y = pk(oB[dt][4 * g + 2] * iB, oB[dt][4 * g + 3] * iB);
            *(u32x2*)(op + 32 * 1024 + 32 * dt + 8 * g) = v; }
    __syncthreads();
#undef U64_LOAD
}
}
#define GAS __attribute__((address_space(1)))
#define LAS __attribute__((address_space(3)))
typedef unsigned short bf16;
typedef unsigned v4u __attribute__((ext_vector_type(4)));
typedef float f32x4 __attribute__((ext_vector_type(4)));
typedef short bf16x8 __attribute__((ext_vector_type(8)));
typedef GAS unsigned gu32;
typedef GAS unsigned long long gu64;
#define RLX_AGENT __ATOMIC_RELAXED, __HIP_MEMORY_SCOPE_AGENT
#define LDS_WAIT() asm volatile("s_waitcnt lgkmcnt(0)" ::: "memory")
#define VM_WAIT() asm volatile("s_waitcnt vmcnt(0)" ::: "memory")
__device__ __forceinline__ unsigned long long rt() { return __builtin_amdgcn_s_memrealtime(); }
__device__ __forceinline__ unsigned f2bf(float f) { unsigned u = __builtin_bit_cast(unsigned, f); return (u + 0x7fffu + ((u >> 16) & 1u)) >> 16; }
__device__ __forceinline__ unsigned pk2(float lo, float hi) { return f2bf(lo) | (f2bf(hi) << 16); }

#define XB_TMO      128
#define XB_XCNT(j)  (256  + 64 * (j))
#define XB_XSUB(j)  (1280 + 64 * (j))
#define XB_XGEN(j)  (2304 + 64 * (j))
#define XB_TOP      3328
#define XB_TOPGEN   3392
#define XCD_BAR_WORDS 3456
#define XB_SPIN_CAP (1u << 18)

__device__ __forceinline__ unsigned xb_ld(unsigned* p)              { return __hip_atomic_load(p, __ATOMIC_RELAXED, __HIP_MEMORY_SCOPE_AGENT); }
__device__ __forceinline__ unsigned xb_add(unsigned* p, unsigned v) { return __hip_atomic_fetch_add(p, v, __ATOMIC_RELAXED, __HIP_MEMORY_SCOPE_AGENT); }
__device__ __forceinline__ unsigned xb_xcc_id() { return (unsigned)__builtin_amdgcn_s_getreg((3 << 11) | 20) & 0xFu; }
#define XB_SPIN(cond, bar) do { unsigned _sp = 0; while (cond) { __builtin_amdgcn_s_sleep(1); \
    if ((++_sp & 255u) == 0u) { if (xb_ld(&(bar)[XB_TMO])) break; if (_sp > XB_SPIN_CAP) { atomicAdd(&(bar)[XB_TMO], 1u); break; } } } } while (0)

struct XcdBarrier {
    unsigned* bar; unsigned x;
    volatile LAS unsigned* st;
};

__device__ __forceinline__ XcdBarrier xcd_barrier_post(unsigned* bar, volatile LAS unsigned* st) {
    XcdBarrier b; b.bar = bar; b.x = xb_xcc_id(); b.st = st;
    if (threadIdx.x == 0) (void)xb_add(&bar[XB_XCNT(b.x)], 1u);
    return b;
}
__device__ __forceinline__ void xcd_barrier_complete(unsigned* bar, unsigned x, unsigned& nloc, unsigned& nx) {
    const unsigned G = gridDim.x * gridDim.y * gridDim.z;
    unsigned sum, cnt, mine, sp = 0u;
    for (;;) {
        sum = 0u; cnt = 0u; mine = 0u;
#pragma unroll
        for (unsigned j = 0; j < 16; ++j) { const unsigned c = xb_ld(&bar[XB_XCNT(j)]); sum += c; cnt += (c > 0u) ? 1u : 0u; mine = (j == x) ? c : mine; }
        if (sum == G) break;
        __builtin_amdgcn_s_sleep(1);
        if ((++sp & 255u) == 0u) { if (xb_ld(&bar[XB_TMO])) break; if (sp > XB_SPIN_CAP) { atomicAdd(&bar[XB_TMO], 1u); break; } }
    }
    nloc = mine > 0u ? mine : 1u; nx = cnt > 0u ? cnt : 1u;
}

__device__ __forceinline__ void xcd_barrier(const XcdBarrier& b) {
    asm volatile("s_waitcnt vmcnt(0)" ::: "memory");
    __syncthreads();
    if (threadIdx.x == 0) {
        unsigned* bar = b.bar;
        __builtin_amdgcn_s_waitcnt(0);
        unsigned nloc = b.st[0], nx = b.st[1];
        if (nloc == 0u) { xcd_barrier_complete(bar, b.x, nloc, nx); b.st[0] = nloc; b.st[1] = nx; }
        const unsigned old = xb_add(&bar[XB_XSUB(b.x)], 1u);
        const unsigned gen = old / nloc;
        if (old + 1u == (gen + 1u) * nloc) {
            __builtin_amdgcn_fence(__ATOMIC_RELEASE, "agent");
            asm volatile("s_waitcnt vmcnt(0)" ::: "memory");
            const unsigned og = xb_add(&bar[XB_TOP], 1u);
            const unsigned tg = og / nx;
            if (og + 1u == (tg + 1u) * nx) xb_add(&bar[XB_TOPGEN], 1u);
            else XB_SPIN(xb_ld(&bar[XB_TOPGEN]) == tg, bar);
            __builtin_amdgcn_fence(__ATOMIC_ACQUIRE, "agent");
            xb_add(&bar[XB_XGEN(b.x)], 1u);
            asm volatile("s_waitcnt vmcnt(0)" ::: "memory");
        } else {
            XB_SPIN(xb_ld(&bar[XB_XGEN(b.x)]) == gen, bar);
            __builtin_amdgcn_fence(__ATOMIC_ACQUIRE, "agent");
            asm volatile("s_waitcnt vmcnt(0)" ::: "memory");
        }
    }
    __syncthreads();
}
constexpr int NWAVES = 8, NTHREADS = 512;
constexpr int BATCH = 8, SEQ = 4096, DM = 1024, CTXL = 256, ST = SEQ + CTXL, FFN = 2816, UGC = 2 * FFN, INC = 2304, NSLOT = 36;
constexpr int LAT_ROWS = BATCH * SEQ, CTX_ROWS = BATCH * CTXL, MROWS = LAT_ROWS + CTX_ROWS;
constexpr float EPS = 1e-6f;
constexpr size_t MiB = 1u << 20;
constexpr size_t WS_CTL = 0, CTL_ZERO_BYTES = 1 * MiB;
constexpr size_t WS_MOD = 1 * MiB;
constexpr size_t WS_TAB = 1 * MiB + 512 * 1024;
constexpr size_t WS_W = 2 * MiB, W_LAYER = 23 * MiB, W_IN = 0, W_OUT = 4 * MiB + 512 * 1024, W_UP = 6 * MiB + 512 * 1024, W_DN = 17 * MiB + 512 * 1024;
constexpr size_t WS_XC = 48 * MiB;
constexpr size_t WS_XN = 56 * MiB;
constexpr size_t WS_QKV = 124 * MiB;
constexpr size_t WS_UG = 124 * MiB;
constexpr size_t WS_ACT = 124 * MiB;
constexpr size_t WS_SB = 322 * MiB;
constexpr size_t WS_END = 370 * MiB;
constexpr size_t WS_DUMMY = 370 * MiB;
static_assert(WS_QKV + (size_t)BATCH * NSLOT * ST * 64 * 2 <= WS_SB && WS_ACT + (size_t)MROWS * FFN * 2 <= WS_SB && WS_SB + (size_t)(MROWS / 64) * 4 * UGC * 4 <= WS_END, "ws map");
static_assert(WS_XN + (size_t)MROWS * DM * 2 <= WS_QKV && WS_W + 2 * W_LAYER <= WS_XC, "ws map 2");
constexpr int CW_BAR = 4096;
constexpr int LDS_BYTES = 147456, MISC_OFF = 131072 + 320;
constexpr int P0_SCR = 8704, P0_SILU = 73728;
constexpr int TAB_LDS = 131072 + 1024;
static_assert(TAB_LDS + 12288 <= LDS_BYTES, "LDS map");
#ifndef AT_REPEAT
#define AT_REPEAT 1
#endif
#ifndef AT_ABL
#define AT_ABL 0
#endif
#ifndef REP_P0
#define REP_P0 1
#endif
#ifndef REP_N
#define REP_N 1
#endif
#ifndef REP_G1
#define REP_G1 1
#endif
#ifndef REP_G3
#define REP_G3 1
#endif
#ifndef PH_G1
#define PH_G1 1
#endif
#ifndef PH_AT
#define PH_AT 1
#endif
#ifndef PH_G2
#define PH_G2 1
#endif
#ifndef PH_G3
#define PH_G3 1
#endif
#ifndef PH_G4
#define PH_G4 1
#endif


__device__ __forceinline__ float wave_sum(float v) {
    int ln = (int)__lane_id(); asm volatile("" : "+v"(ln));
#pragma unroll
    for (int o = 1; o < 64; o <<= 1) v += __builtin_bit_cast(float, __builtin_amdgcn_ds_bpermute((ln ^ o) << 2, __builtin_bit_cast(int, v)));
    return v;
}
__device__ __forceinline__ void p0_transpose_item(const float* W, int K, int N, bf16* WT, LAS float* scr, int kb, int n0, int dn0, int lane) {
    const int k0 = 64 * kb;
#pragma unroll 16
    for (int i = 0; i < 32; ++i) { const int kk = 2 * i + (lane >> 5); scr[kk * 33 + (lane & 31)] = W[(size_t)(k0 + kk) * N + n0 + (lane & 31)]; }
    LDS_WAIT(); asm volatile("" ::: "memory");
    const int c = lane & 7;
#pragma unroll
    for (int j = 0; j < 4; ++j) { const int n = (lane >> 3) + 8 * j; const LAS float* s = scr + (8 * c) * 33 + n;
        v4u o; o.x = pk2(s[0 * 33], s[1 * 33]); o.y = pk2(s[2 * 33], s[3 * 33]); o.z = pk2(s[4 * 33], s[5 * 33]); o.w = pk2(s[6 * 33], s[7 * 33]);
        *(GAS v4u*)(WT + (size_t)(dn0 + n) * K + k0 + 8 * c) = o; }
    LDS_WAIT(); asm volatile("" ::: "memory");
}
struct Args { const float* in[26]; float* out; unsigned char* ws; };

__device__ __forceinline__ void norm_phase(const float* src_lat, const float* src_ctx, const float* g, const float* mod, int sh_off, int sc_off, bf16* XN, int r_begin, int r_end, int gw, int NGW, int lane) {
    f32x4 gv[4];
#pragma unroll
    for (int j = 0; j < 4; ++j) gv[j] = *(const f32x4*)(g + 4 * lane + 256 * j);
    for (int m = r_begin + gw; m < r_end; m += NGW) {
        const bool lat = m < LAT_ROWS;
        const float* xr = lat ? src_lat + (size_t)m * DM : src_ctx + (size_t)(m - LAT_ROWS) * DM;
        const float* mr = mod + (size_t)(lat ? (m >> 12) : 8) * 6144;
        f32x4 v[4]; float s = 0.f;
#pragma unroll
        for (int j = 0; j < 4; ++j) { v[j] = *(const f32x4*)(xr + 4 * lane + 256 * j); s += (v[j].x * v[j].x + v[j].y * v[j].y) + (v[j].z * v[j].z + v[j].w * v[j].w); }
        const float rstd = rsqrtf(wave_sum(s) * (1.f / DM) + EPS);
        unsigned long long* o8 = (unsigned long long*)(XN + (size_t)m * DM) + lane;
#pragma unroll
        for (int j = 0; j < 4; ++j) { const f32x4 sh = *(const f32x4*)(mr + sh_off + 4 * lane + 256 * j), sc = *(const f32x4*)(mr + sc_off + 4 * lane + 256 * j);
            const f32x4 y = ((v[j] * rstd) * gv[j]) * (sc + 1.0f) + sh;
            o8[64 * j] = (unsigned long long)pk2(y.x, y.y) | ((unsigned long long)pk2(y.z, y.w) << 32); }
    }
}
__device__ __forceinline__ float bf_lo(unsigned w) { return __uint_as_float(w << 16); }
__device__ __forceinline__ float bf_hi(unsigned w) { return __uint_as_float(w & 0xffff0000u); }
__device__ __forceinline__ float silu_f(float x) { return x / (1.f + __expf(-x)); }
__device__ __forceinline__ void conv_load8(const bf16* p, float (&o)[8]) { const v4u w = *(const v4u*)p; o[0] = bf_lo(w.x); o[1] = bf_hi(w.x); o[2] = bf_lo(w.y); o[3] = bf_hi(w.y); o[4] = bf_lo(w.z); o[5] = bf_hi(w.z); o[6] = bf_lo(w.w); o[7] = bf_hi(w.w); }
__device__ __forceinline__ void conv_phase(const bf16* UG, bf16* ACT, const float* cw, const float* cb, int row0, int nrows, int gtid, int NGT) {
    constexpr int RB = 16;
    const int total = (nrows / RB) * 352;
    for (int it = gtid; it < total; it += NGT) {
        const int rb = it / 352, c8 = (it - rb * 352) * 8, rr0 = rb * RB, r0 = row0 + rr0;
        const int per = r0 < LAT_ROWS ? SEQ : CTXL;
        const bool first = (r0 % per) == 0, last = ((r0 + RB) % per) == 0;
        float wu[3][8], wg[3][8], bu[8], bg[8];
#pragma unroll
        for (int t = 0; t < 3; ++t)
#pragma unroll
            for (int q = 0; q < 2; ++q) { const f32x4 a = *(const f32x4*)(cw + t * UGC + c8 + 4 * q), g = *(const f32x4*)(cw + t * UGC + FFN + c8 + 4 * q);
                wu[t][4 * q] = a.x; wu[t][4 * q + 1] = a.y; wu[t][4 * q + 2] = a.z; wu[t][4 * q + 3] = a.w; wg[t][4 * q] = g.x; wg[t][4 * q + 1] = g.y; wg[t][4 * q + 2] = g.z; wg[t][4 * q + 3] = g.w; }
#pragma unroll
        for (int q = 0; q < 2; ++q) { const f32x4 a = *(const f32x4*)(cb + c8 + 4 * q), g = *(const f32x4*)(cb + FFN + c8 + 4 * q);
            bu[4 * q] = a.x; bu[4 * q + 1] = a.y; bu[4 * q + 2] = a.z; bu[4 * q + 3] = a.w; bg[4 * q] = g.x; bg[4 * q + 1] = g.y; bg[4 * q + 2] = g.z; bg[4 * q + 3] = g.w; }
        const bf16* pu = UG + (size_t)rr0 * UGC + c8;
        float up[8], uc[8], un[8], gp[8], gc[8], gn[8];
        if (first) {
#pragma unroll
            for (int i = 0; i < 8; ++i) { up[i] = 0.f; gp[i] = 0.f; }
        } else { conv_load8(pu - UGC, up); conv_load8(pu - UGC + FFN, gp); }
        conv_load8(pu, uc); conv_load8(pu + FFN, gc);
#pragma unroll 4
        for (int k = 0; k < RB; ++k) {
            if (k == RB - 1 && last) {
#pragma unroll
                for (int i = 0; i < 8; ++i) { un[i] = 0.f; gn[i] = 0.f; }
            } else { conv_load8(pu + (size_t)(k + 1) * UGC, un); conv_load8(pu + (size_t)(k + 1) * UGC + FFN, gn); }
            float res[8];
#pragma unroll
            for (int i = 0; i < 8; ++i) {
                const float u = up[i] * wu[0][i] + uc[i] * wu[1][i] + un[i] * wu[2][i] + bu[i];
                const float g = gp[i] * wg[0][i] + gc[i] * wg[1][i] + gn[i] * wg[2][i] + bg[i];
                res[i] = silu_f(g) * u;
                up[i] = uc[i]; uc[i] = un[i]; gp[i] = gc[i]; gc[i] = gn[i];
            }
            v4u w; w.x = pk2(res[0], res[1]); w.y = pk2(res[2], res[3]); w.z = pk2(res[4], res[5]); w.w = pk2(res[6], res[7]);
            *(v4u*)(ACT + (size_t)(rr0 + k) * FFN + c8) = w;
        }
    }
}

__device__ __forceinline__ void fix_phase(const float* SB, bf16* ACT, const float* cw, const float* cb, int nseg, int gtid, int NGT) {
    const int total = nseg * 2 * 352;
    for (int it = gtid; it < total; it += NGT) {
        const int t = it / 352, c8 = (it - t * 352) * 8, side = t & 1, seg = t >> 1;
        const int row = seg * 64 + (side ? 63 : 0), per = row < LAT_ROWS ? SEQ : CTXL;
        const bool edge = side ? (((row + 1) % per) == 0) : ((row % per) == 0);
        const float* pc = SB + (size_t)(seg * 4 + (side ? 3 : 0)) * UGC + c8;
        const float* pp = side ? pc - UGC : pc - UGC;
        const float* pn = pc + UGC;
        float res[8];
#pragma unroll
        for (int half = 0; half < 2; ++half) {
            const int col = half * FFN + c8;
            float o[8];
#pragma unroll
            for (int q = 0; q < 2; ++q) {
                const f32x4 z = {0.f, 0.f, 0.f, 0.f};
                const f32x4 a = (!side && edge) ? z : *(const f32x4*)(pp + half * FFN + 4 * q), b = *(const f32x4*)(pc + half * FFN + 4 * q), c = (side && edge) ? z : *(const f32x4*)(pn + half * FFN + 4 * q);
                const f32x4 w0 = *(const f32x4*)(cw + col + 4 * q), w1 = *(const f32x4*)(cw + UGC + col + 4 * q), w2 = *(const f32x4*)(cw + 2 * UGC + col + 4 * q), bb = *(const f32x4*)(cb + col + 4 * q);
                const f32x4 v = a * w0 + b * w1 + c * w2 + bb;
                o[4 * q] = v.x; o[4 * q + 1] = v.y; o[4 * q + 2] = v.z; o[4 * q + 3] = v.w;
            }
            if (half == 0) {
#pragma unroll
                for (int i = 0; i < 8; ++i) res[i] = o[i];
            } else {
#pragma unroll
                for (int i = 0; i < 8; ++i) res[i] = silu_f(o[i]) * res[i];
            }
        }
        v4u w; w.x = pk2(res[0], res[1]); w.y = pk2(res[2], res[3]); w.z = pk2(res[4], res[5]); w.w = pk2(res[6], res[7]);
        *(v4u*)(ACT + (size_t)row * FFN + c8) = w;
    }
}

typedef const __attribute__((address_space(4))) Args* ArgsP;
#define GET_ARGS() ({ ArgsP _p = (ArgsP)__builtin_amdgcn_kernarg_segment_ptr(); asm volatile("" : "+s"(_p)); _p; })
__global__ void __launch_bounds__(NTHREADS, 2) fwd_megakernel(Args args_unused) {
    extern __shared__ __attribute__((aligned(16))) unsigned char lds_raw[];
    LAS unsigned char* lds = (LAS unsigned char*)lds_raw;
    const int G = gridDim.x, bx = blockIdx.x;
    const int vcu = (G % 8 == 0) ? (bx % 8) * (G / 8) + bx / 8 : bx;
    const int NGW = G * NWAVES;
#define PHASE_IDS() int tid = threadIdx.x; asm volatile("" : "+v"(tid)); const int lane = tid & 63, wave = __builtin_amdgcn_readfirstlane(tid >> 6), gw = vcu * NWAVES + wave; (void)lane; (void)gw
    for (int u = threadIdx.x; u < (LDS_BYTES - 131072) / 4; u += NTHREADS) ((LAS unsigned*)(lds + 131072))[u] = 0u;
    __syncthreads();
    XcdBarrier bar;
    { ArgsP A = GET_ARGS(); bar = xcd_barrier_post((unsigned*)(A->ws + WS_CTL) + CW_BAR, (volatile LAS unsigned*)(lds + MISC_OFF) + 8); }
#ifndef BAR_REP
#define BAR_REP 1
#endif
#define GRID_BAR() do { for (int br_ = 0; br_ < BAR_REP; ++br_) xcd_barrier(bar); } while (0)

    for (int rep_ = 0; rep_ < REP_P0; ++rep_) {
        PHASE_IDS();
        ArgsP A = GET_ARGS();
        unsigned char* ws = A->ws;
        LAS float* silu = (LAS float*)(lds + P0_SILU);
        { const float* c_in = A->in[1]; const float* cctx_in = A->in[3];
          for (int i = tid; i < 9 * 1024; i += NTHREADS) { const float v = (i < 8192) ? c_in[i] : cctx_in[i - 8192]; silu[i] = silu_f(v); } }
        __syncthreads();
        if (gw < 768) {
            const int l = gw / 384, col = (gw % 384) * 16 + (lane & 15), kq = lane >> 4;
            const float* wp = A->in[4] + (size_t)l * DM * 6144 + col;
            float* mod = (float*)(ws + WS_MOD);
            float a[9];
#pragma unroll
            for (int r = 0; r < 9; ++r) a[r] = 0.f;
#pragma unroll 16
            for (int k = kq; k < DM; k += 4) { const float w = wp[(size_t)k * 6144];
#pragma unroll
                for (int r = 0; r < 9; ++r) a[r] += silu[r * 1024 + k] * w; }
#pragma unroll
            for (int r = 0; r < 9; ++r) { a[r] += __shfl_xor(a[r], 16); a[r] += __shfl_xor(a[r], 32); }
            if (kq == 0) { const float bb = A->in[5][l * 6144 + col];
#pragma unroll
                for (int r = 0; r < 9; ++r) mod[(size_t)(l * 9 + r) * 6144 + col] = a[r] + bb; }
        }
        if (bx == 0) {
            float* tabA = (float*)(ws + WS_TAB); float* tabC = (float*)(ws + WS_TAB + 8192);
            for (int i = tid; i < 64 * 24; i += NTHREADS) {
                const int pos = i / 24, f = i % 24;
                const float inv = (f < 16) ? exp2f(-(float)(2 * f) * (1.f / 32.f) * 13.287712379549449f) : exp2f(-(float)(2 * (f - 16)) * (1.f / 16.f) * 13.287712379549449f);
                const float ang = (float)pos * inv;
                const double rev = (double)ang * 0.15915494309189535; const float fr = (float)(rev - floor(rev));
                const float cv = __builtin_amdgcn_cosf(fr), sv = __builtin_amdgcn_sinf(fr);
                if (f < 16) { tabA[(pos * 16 + f) * 2] = cv; tabA[(pos * 16 + f) * 2 + 1] = sv; } else { tabC[(pos * 8 + f - 16) * 2] = cv; tabC[(pos * 8 + f - 16) * 2 + 1] = sv; }
            }
        }
        LAS float* scr = (LAS float*)(lds + wave * P0_SCR);
        constexpr int I_IN = 16 * 72, I_OUT = 16 * 32, I_UP = 16 * 176, I_DN = 44 * 32, I_L = I_IN + I_OUT + I_UP + I_DN;
        for (int it = gw; it < 2 * I_L; it += NGW) {
            const int l = it / I_L; int r = it % I_L;
            bf16* wb = (bf16*)(ws + WS_W + (size_t)l * W_LAYER);
            if (r < I_IN) { const int kb = r / 72, nb = r % 72, n0 = nb * 32;
                const int pn = n0 >> 8, wc = (n0 >> 6) & 3, bj = (n0 >> 5) & 1;
                p0_transpose_item(A->in[7] + (size_t)l * DM * INC, DM, INC, (bf16*)((unsigned char*)wb + W_IN), scr, kb, n0, pn * 256 + bj * 128 + wc * 32, lane); continue; }
            r -= I_IN;
            if (r < I_OUT) { const int kb = r / 32, nb = r % 32; p0_transpose_item(A->in[20] + (size_t)l * DM * DM, DM, DM, (bf16*)((unsigned char*)wb + W_OUT), scr, kb, nb * 32, nb * 32, lane); continue; }
            r -= I_OUT;
            if (r < I_UP) { const int kb = r / 176, nb = r % 176, n0 = nb * 32, which = n0 / FFN, jj = n0 - which * FFN;
                p0_transpose_item(A->in[22] + (size_t)l * DM * UGC, DM, UGC, (bf16*)((unsigned char*)wb + W_UP), scr, kb, n0, (jj >> 7) * 256 + which * 128 + (jj & 127), lane); continue; }
            r -= I_UP;
            { const int kb = r / 32, nb = r % 32; p0_transpose_item(A->in[25] + (size_t)l * FFN * DM, FFN, DM, (bf16*)((unsigned char*)wb + W_DN), scr, kb, nb * 32, nb * 32, lane); }
        }
    }
    asm volatile("s_waitcnt vmcnt(0)" ::: "memory");
    cg::this_grid().sync();


    for (int l = 0; l < 2; ++l) {
        const bool with_ctx = (l == 0);
        const int mrows = with_ctx ? MROWS : LAT_ROWS;
        if (l == 0) {
            for (int rep_ = 0; rep_ < REP_N; ++rep_) { PHASE_IDS(); ArgsP A = GET_ARGS(); unsigned char* ws = A->ws;
              norm_phase(A->in[0], A->in[2], A->in[6], (const float*)(ws + WS_MOD), 0, 1024, (bf16*)(ws + WS_XN), 0, MROWS, gw, NGW, lane); }
            GRID_BAR();
        }
        for (int rep_ = 0; rep_ < REP_G1; ++rep_) if (PH_G1) {
            ArgsP A = GET_ARGS(); unsigned char* ws = A->ws;
            pg8::Gemm g{(const bf16*)(ws + WS_XN), (const bf16*)(ws + WS_W + (size_t)l * W_LAYER + W_IN), MROWS, INC, DM}; pg8::StaticOrder S; S.init(MROWS, INC, G, bx);
            { PHASE_IDS(); const float* tsrc = (const float*)(ws + WS_TAB);
              for (int i = tid; i < 3072; i += NTHREADS) ((LAS float*)(lds + TAB_LDS))[i] = tsrc[i];
              __syncthreads(); }
            pg8::EpiQKV E{(pg8::QkvArgsP)A, l, (unsigned)WS_QKV, (const LAS float*)(lds + TAB_LDS)};
            pg8::gemm_phase<pg8::EpiQKV, pg8::StaticOrder, true, true>(lds, g, S, E);
        }
        GRID_BAR();
        for (int rep_ = 0; rep_ < AT_REPEAT; ++rep_) if (PH_AT) {
            ArgsP A = GET_ARGS(); unsigned char* ws = A->ws;
            bool fxA, fxC;
            { const int li = (int)(threadIdx.x & 63u);
              float mqa = fabsf(A->in[8][l * 64 + li]), mka = fabsf(A->in[9][l * 64 + li]), mqc = fabsf(A->in[13][l * 32 + (li & 31)]), mkc = fabsf(A->in[14][l * 32 + (li & 31)]);
              int ln = (int)__lane_id(); asm volatile("" : "+v"(ln));
#pragma unroll
              for (int o = 1; o < 64; o <<= 1) {
                  mqa = fmaxf(mqa, __builtin_bit_cast(float, __builtin_amdgcn_ds_bpermute((ln ^ o) << 2, __builtin_bit_cast(int, mqa))));
                  mka = fmaxf(mka, __builtin_bit_cast(float, __builtin_amdgcn_ds_bpermute((ln ^ o) << 2, __builtin_bit_cast(int, mka))));
                  mqc = fmaxf(mqc, __builtin_bit_cast(float, __builtin_amdgcn_ds_bpermute((ln ^ o) << 2, __builtin_bit_cast(int, mqc))));
                  mkc = fmaxf(mkc, __builtin_bit_cast(float, __builtin_amdgcn_ds_bpermute((ln ^ o) << 2, __builtin_bit_cast(int, mkc)))); }
              fxA = __builtin_amdgcn_readfirstlane((int)(11.7f * mqa * mka < 30.f)) != 0; fxC = __builtin_amdgcn_readfirstlane((int)(8.3f * mqc * mkc < 30.f)) != 0; }
            const float lam_init = (l == 0) ? 0.2f : 0.35550906759096946f;
            float d1, d2;
            { const int li = (int)(threadIdx.x & 31u);
              d1 = wave_sum(A->in[15][l * 32 + li] * A->in[16][l * 32 + li]) * 0.5f; d2 = wave_sum(A->in[17][l * 32 + li] * A->in[18][l * 32 + li]) * 0.5f; }
            d1 = __builtin_bit_cast(float, __builtin_amdgcn_readfirstlane(__builtin_bit_cast(int, d1))); d2 = __builtin_bit_cast(float, __builtin_amdgcn_readfirstlane(__builtin_bit_cast(int, d2)));
            const bool abl_pass = (AT_ABL != 0) && (rep_ == 0);
            att::Params P{(const bf16*)(ws + WS_QKV), abl_pass ? (bf16*)(ws + WS_DUMMY) : (bf16*)(ws + WS_XN), A->in[12] + (size_t)l * 4 * 465, A->in[19] + l * 64, expf(d1) - expf(d2) + lam_init, 1.f - lam_init};
            if (AT_ABL != 0 && abl_pass) {
                for (int u = vcu; u < 1024; u += G) { const int b = u >> 7, hq = (u >> 4) & 7, qb = u & 15;
                    att::unit<0, AT_ABL>(P, lds, b, hq, 8 + (hq >> 2), 10 + (hq >> 2), qb * 256, 0, 68, hq * 64, 0); }
                for (int u = vcu; u < 512; u += G) { const int b = u >> 6, hc = (u >> 4) & 3, qb = u & 15;
                    att::unit<1, AT_ABL>(P, lds, b, 24 + hc, 28 + hc, 32 + hc, qb * 256, 0, 68, 768 + hc * 64, 0); }
                continue;
            }
            if (fxA) { for (int u = vcu; u < 512; u += G) { const int b = u >> 6, hq = (u >> 3) & 7, qb = u & 7;
                att::unit64<true>(P, lds, b, hq, 8 + (hq >> 2), 10 + (hq >> 2), qb * 512, 68, hq * 64); } }
            else { for (int u = vcu; u < 512; u += G) { const int b = u >> 6, hq = (u >> 3) & 7, qb = u & 7;
                att::unit64<false>(P, lds, b, hq, 8 + (hq >> 2), 10 + (hq >> 2), qb * 512, 68, hq * 64); } }
            if (fxC) { for (int u = vcu; u < 512; u += G) { const int b = u >> 6, hc = (u >> 4) & 3, qb = u & 15;
                att::unit<1, 0, true>(P, lds, b, 24 + hc, 28 + hc, 32 + hc, qb * 256, 0, 68, 768 + hc * 64, 0); } }
            else { for (int u = vcu; u < 512; u += G) { const int b = u >> 6, hc = (u >> 4) & 3, qb = u & 15;
                att::unit<1>(P, lds, b, 24 + hc, 28 + hc, 32 + hc, qb * 256, 0, 68, 768 + hc * 64, 0); } }
            for (int u = vcu; u < 512; u += G) { const int b = u >> 6, hb = (u >> 4) & 3, qb = u & 15;
                att::unit<2>(P, lds, b, 12 + hb, 16 + hb, 20 + hb, qb * 256, 0, 0, 512 + hb * 64, hb); }
            if (with_ctx) for (int u = vcu; u < 128; u += G) { const int b = u >> 4, hh = u & 15;
                if (hh < 12) { const int qs = hh < 8 ? hh : 12 + (hh - 8), ks = hh < 8 ? 8 + (hh >> 2) : 16 + (hh - 8), vs = hh < 8 ? 10 + (hh >> 2) : 20 + (hh - 8), oc = hh < 8 ? hh * 64 : 512 + (hh - 8) * 64;
                    att::unit<0>(P, lds, b, qs, ks, vs, SEQ, 64, 4, oc, 0); }
                else att::unit<1>(P, lds, b, 24 + (hh - 12), 28 + (hh - 12), 32 + (hh - 12), SEQ, 64, 4, 768 + (hh - 12) * 64, 0); }
        }
        GRID_BAR();
        for (int part = 0; part < (with_ctx ? 2 : 1); ++part) {
            if (part == 0 || bx < 32) {
                if (PH_G2) {
                    ArgsP A = GET_ARGS(); unsigned char* ws = A->ws;
                    const int rows = part ? CTX_ROWS : LAT_ROWS, roff = part ? LAT_ROWS : 0;
                    pg8::Gemm g{(const bf16*)(ws + WS_XN) + (size_t)roff * DM, (const bf16*)(ws + WS_W + (size_t)l * W_LAYER + W_OUT), rows, DM, DM}; pg8::StaticOrder S; S.init(rows, DM, G, bx);
                    pg8::EpiGateRes E{(l == 0) ? A->in[0] : A->out, (l == 0) ? A->in[2] : (const float*)(ws + WS_XC), A->out, (float*)(ws + WS_XC), (const float*)(ws + WS_MOD) + (size_t)l * 9 * 6144 + 2048, 6144, roff};
                    pg8::gemm_phase<pg8::EpiGateRes, pg8::StaticOrder, true, true>(lds, g, S, E);
                }
            } else { PHASE_IDS(); ArgsP A = GET_ARGS(); unsigned char* ws = A->ws;
                norm_phase(A->out, (const float*)(ws + WS_XC), A->in[21] + l * DM, (const float*)(ws + WS_MOD) + (size_t)l * 9 * 6144, 3072, 4096, (bf16*)(ws + WS_XN), 0, LAT_ROWS, (bx - 32) * NWAVES + wave, (G - 32) * NWAVES, lane); }
            GRID_BAR();
        }
        for (int rep_ = 0; rep_ < REP_N; ++rep_) { PHASE_IDS(); ArgsP A = GET_ARGS(); unsigned char* ws = A->ws;
          norm_phase(A->out, (const float*)(ws + WS_XC), A->in[21] + l * DM, (const float*)(ws + WS_MOD) + (size_t)l * 9 * 6144, 3072, 4096, (bf16*)(ws + WS_XN), with_ctx ? LAT_ROWS : 0, with_ctx ? MROWS : LAT_ROWS, gw, NGW, lane); }
        GRID_BAR();
        for (int rep_ = 0; rep_ < REP_G3; ++rep_) if (PH_G3) {
            ArgsP A = GET_ARGS(); unsigned char* ws = A->ws;
            pg8::Gemm g{(const bf16*)(ws + WS_XN), (const bf16*)(ws + WS_W + (size_t)l * W_LAYER + W_UP), mrows, UGC, DM}; pg8::StaticOrder S; S.init(mrows, UGC, G, bx);
            pg8::EpiConv E{(bf16*)(ws + WS_ACT), (float*)(ws + WS_SB), A->in[23] + (size_t)l * 3 * UGC, A->in[24] + (size_t)l * UGC};
            pg8::gemm_phase<pg8::EpiConv, pg8::StaticOrder, true, true>(lds, g, S, E);
        }
        GRID_BAR();
        { PHASE_IDS(); ArgsP A = GET_ARGS(); unsigned char* ws = A->ws;
          fix_phase((const float*)(ws + WS_SB), (bf16*)(ws + WS_ACT), A->in[23] + (size_t)l * 3 * UGC, A->in[24] + (size_t)l * UGC, mrows / 64, vcu * NTHREADS + tid, G * NTHREADS); }
        GRID_BAR();
        for (int part = 0; part < (with_ctx ? 2 : 1); ++part) {
            if (part == 0 || bx < 32) {
                if (PH_G4) {
                    ArgsP A = GET_ARGS(); unsigned char* ws = A->ws;
                    const int rows = part ? CTX_ROWS : LAT_ROWS, roff = part ? LAT_ROWS : 0;
                    pg8::Gemm g{(const bf16*)(ws + WS_ACT) + (size_t)roff * FFN, (const bf16*)(ws + WS_W + (size_t)l * W_LAYER + W_DN), rows, DM, FFN}; pg8::StaticOrder S; S.init(rows, DM, G, bx);
                    pg8::EpiGateRes E{A->out, (const float*)(ws + WS_XC), A->out, (float*)(ws + WS_XC), (const float*)(ws + WS_MOD) + (size_t)l * 9 * 6144 + 5120, 6144, roff};
                    pg8::gemm_phase<pg8::EpiGateRes, pg8::StaticOrder, true, true>(lds, g, S, E);
                }
            } else { PHASE_IDS(); ArgsP A = GET_ARGS(); unsigned char* ws = A->ws;
                norm_phase(A->out, (const float*)(ws + WS_XC), A->in[6] + DM, (const float*)(ws + WS_MOD) + (size_t)9 * 6144, 0, 1024, (bf16*)(ws + WS_XN), 0, LAT_ROWS, (bx - 32) * NWAVES + wave, (G - 32) * NWAVES, lane); }
            if (l == 0) GRID_BAR();
        }
        if (l == 0) {
            { PHASE_IDS(); ArgsP A = GET_ARGS(); unsigned char* ws = A->ws;
              norm_phase(A->out, (const float*)(ws + WS_XC), A->in[6] + DM, (const float*)(ws + WS_MOD) + (size_t)9 * 6144, 0, 1024, (bf16*)(ws + WS_XN), LAT_ROWS, MROWS, gw, NGW, lane); }
            GRID_BAR();
        }
    }
}

extern "C" void kernel_launch(void* const* d_in, const int* in_sizes, int n_in, void* d_out, int out_size, void* d_ws, size_t ws_size, hipStream_t stream) {
    static int grid = 0;
    if (grid == 0) {
        int dev = 0, cus = 0, per_cu = 0;
        if (n_in != 26 || ws_size < WS_END) { fprintf(stderr, "kernel_launch: unexpected n_in %d / ws %zu\n", n_in, ws_size); grid = -1; return; }
        if (hipGetDevice(&dev) != hipSuccess || hipDeviceGetAttribute(&cus, hipDeviceAttributeMultiprocessorCount, dev) != hipSuccess) { grid = -1; return; }
        if (hipFuncSetAttribute((const void*)fwd_megakernel, hipFuncAttributeMaxDynamicSharedMemorySize, LDS_BYTES) != hipSuccess) { fprintf(stderr, "kernel_launch: hipFuncSetAttribute failed\n"); grid = -1; return; }
        if (hipOccupancyMaxActiveBlocksPerMultiprocessor(&per_cu, (const void*)fwd_megakernel, NTHREADS, LDS_BYTES) != hipSuccess || per_cu < 1) per_cu = 1;
        (void)hipGetLastError();
        grid = cus;
    }
    if (grid < 0) return;
    (void)hipMemsetAsync((char*)d_ws + WS_CTL, 0, CTL_ZERO_BYTES, stream);
    Args a{};
    for (int i = 0; i < 26; ++i) a.in[i] = (const float*)d_in[i];
    a.out = (float*)d_out; a.ws = (unsigned char*)d_ws;
    void* kargs[] = {&a};
    hipError_t e = hipLaunchCooperativeKernel((const void*)fwd_megakernel, dim3(grid), dim3(NTHREADS), kargs, LDS_BYTES, stream);
    if (e != hipSuccess) fprintf(stderr, "cooperative launch failed: %s (grid %d)\n", hipGetErrorString(e), grid);
}
```
